# Optimizing an MI355X kernel written in HIP

```python
import math
import jax, jax.numpy as jnp
from jax import lax
import numpy as np

D_MODEL = 1024
BATCH = 4
SEQ = 4096
DEPTH = 2

HEAD_DIM = 64
N_Q_HEADS = 8
N_KV_HEADS = 2
Q_PER_KV = N_Q_HEADS // N_KV_HEADS
D_ATTN = N_Q_HEADS * HEAD_DIM
D_KV = N_KV_HEADS * HEAD_DIM
ROT_HALF = HEAD_DIM // 2
ROPE_THETA = 10000.0
GRID_W = 64
Q_BLOCK = 128
D_SSM = D_MODEL // 2
SSM_GROUP = 16
N_SSM_GROUPS = D_SSM // SSM_GROUP
SSM_STATE = 64
DT_MIN = 0.001
DT_MAX = 0.1
N_EXPERTS = 16
CAPACITY_FACTOR = 2
D_FF_EXPERT = 2 * D_MODEL
N_IN = D_SSM + D_ATTN + 2 * D_KV + 2 * D_MODEL
SPLITS = (D_SSM, D_SSM + D_ATTN, D_SSM + D_ATTN + D_KV, D_SSM + D_ATTN + 2 * D_KV,
          D_SSM + D_ATTN + 2 * D_KV + D_MODEL)
EPS = 1e-6

kernel_name = "hybrid_s5_gqa_ec_moe_encoder"


def rmsnorm(x, w):
    xf = x.astype(jnp.float32)
    y = xf * lax.rsqrt(jnp.mean(xf * xf, axis=-1, keepdims=True) + EPS)
    return (y * w.astype(jnp.float32)).astype(x.dtype)


def modulate(x, w, shift, scale):
    return rmsnorm(x, w) * (1 + scale[:, None, :]) + shift[:, None, :]


def axial_rope_tables(S):
    rows = S // GRID_W
    row = jnp.repeat(jnp.arange(rows), GRID_W).astype(jnp.float32)
    col = jnp.tile(jnp.arange(GRID_W), rows).astype(jnp.float32)
    inv = 1.0 / (ROPE_THETA ** (jnp.arange(0, ROT_HALF, 2, dtype=jnp.float32) / ROT_HALF))
    ang_r = row[:, None] * inv[None, :]
    ang_c = col[:, None] * inv[None, :]
    return (jnp.cos(ang_r), jnp.sin(ang_r), jnp.cos(ang_c), jnp.sin(ang_c))


def rope_1d(x, cos, sin):
    x1, x2 = jnp.split(x, 2, axis=-1)
    cos = cos[None, :, None, :]
    sin = sin[None, :, None, :]
    return jnp.concatenate([x1 * cos - x2 * sin, x1 * sin + x2 * cos], axis=-1)


def rope_axial(x, tabs):
    cr, sr, cc, sc = tabs
    xf = x.astype(jnp.float32)
    xr, xc = jnp.split(xf, 2, axis=-1)
    out = jnp.concatenate([rope_1d(xr, cr, sr), rope_1d(xc, cc, sc)], axis=-1)
    return out.astype(x.dtype)


def block_attention(q, k, v):
    B, S = q.shape[0], q.shape[1]
    nb = S // Q_BLOCK
    qb = q.reshape(B, nb, Q_BLOCK, N_KV_HEADS, Q_PER_KV, HEAD_DIM).transpose(1, 0, 2, 3, 4, 5)
    scale = HEAD_DIM ** -0.5

    def one_block(qi):
        s = jnp.einsum('bqhgd,bshd->bhgqs', qi, k).astype(jnp.float32) * scale
        p = jax.nn.softmax(s, axis=-1).astype(v.dtype)
        return jnp.einsum('bhgqs,bshd->bqhgd', p, v)

    o = lax.map(one_block, qb)
    return o.transpose(1, 0, 2, 3, 4, 5).reshape(B, S, D_ATTN)


def s5_direction(u_g, lam_re, lam_im, log_dt, b_re, b_im, c_re, c_im, reverse):
    lam_re = lam_re.astype(jnp.float32)
    lam_im = lam_im.astype(jnp.float32)
    dt = jnp.exp(log_dt.astype(jnp.float32))[:, None]
    mag = jnp.exp(lam_re * dt)
    lb_re = mag * jnp.cos(lam_im * dt)
    lb_im = mag * jnp.sin(lam_im * dt)
    nr = lb_re - 1.0
    ni = lb_im
    den = lam_re * lam_re + lam_im * lam_im
    f_re = ((nr * lam_re + ni * lam_im) / den)[..., None]
    f_im = ((ni * lam_re - nr * lam_im) / den)[..., None]
    b_re = b_re.astype(jnp.float32)
    b_im = b_im.astype(jnp.float32)
    bb_re = f_re * b_re - f_im * b_im
    bb_im = f_re * b_im + f_im * b_re
    bu_re = jnp.einsum('bsgc,gpc->bsgp', u_g, bb_re)
    bu_im = jnp.einsum('bsgc,gpc->bsgp', u_g, bb_im)
    a_re = jnp.broadcast_to(lb_re, bu_re.shape)
    a_im = jnp.broadcast_to(lb_im, bu_im.shape)

    def combine(e1, e2):
        a1r, a1i, b1r, b1i = e1
        a2r, a2i, b2r, b2i = e2
        return (a1r * a2r - a1i * a2i,
                a1r * a2i + a1i * a2r,
                a2r * b1r - a2i * b1i + b2r,
                a2r * b1i + a2i * b1r + b2i)

    _, _, x_re, x_im = lax.associative_scan(combine, (a_re, a_im, bu_re, bu_im), axis=1, reverse=reverse)
    return (jnp.einsum('bsgp,gcp->bsgc', x_re, c_re.astype(jnp.float32))
            - jnp.einsum('bsgp,gcp->bsgc', x_im, c_im.astype(jnp.float32)))


def token_mixer(h, tabs, w_in, lam_re, lam_im, log_dt, b_re, b_im, c_re, c_im, d_skip,
                w_glu, b_glu, q_norm_w, k_norm_w, w_ssm_up, w_attn_up, w_out):
    B, S, _ = h.shape
    proj = h @ w_in
    u, q, k, v, g_s, g_a = jnp.split(proj, SPLITS, axis=-1)
    uf = u.astype(jnp.float32)
    ug = uf.reshape(B, S, N_SSM_GROUPS, SSM_GROUP)
    y = (s5_direction(ug, lam_re[0], lam_im[0], log_dt[0], b_re[0], b_im[0], c_re[0], c_im[0], False)
         + s5_direction(ug, lam_re[1], lam_im[1], log_dt[1], b_re[1], b_im[1], c_re[1], c_im[1], True))
    y = y.reshape(B, S, D_SSM) + d_skip.astype(jnp.float32) * uf
    z = jax.nn.gelu(y).astype(h.dtype)
    ssm_out = z * jax.nn.sigmoid(z @ w_glu + b_glu)
    q = rope_axial(rmsnorm(q.reshape(B, S, N_Q_HEADS, HEAD_DIM), q_norm_w), tabs)
    k = rope_axial(rmsnorm(k.reshape(B, S, N_KV_HEADS, HEAD_DIM), k_norm_w), tabs)
    v = v.reshape(B, S, N_KV_HEADS, HEAD_DIM)
    attn_out = block_attention(q, k, v)
    merged = jax.nn.sigmoid(g_s) * (ssm_out @ w_ssm_up) + jax.nn.sigmoid(g_a) * (attn_out @ w_attn_up)
    return merged @ w_out


def expert_choice_moe(h, w_router, w_g, w_u, w_d):
    B, S, D = h.shape
    cap = CAPACITY_FACTOR * S // N_EXPERTS
    aff = jax.nn.softmax((h @ w_router).astype(jnp.float32), axis=-1)
    gates, idx = lax.top_k(jnp.swapaxes(aff, 1, 2), cap)
    xg = jax.vmap(lambda hb, ib: hb[ib])(h, idx)
    hid = jax.nn.silu(jnp.einsum('becd,edf->becf', xg, w_g)) * jnp.einsum('becd,edf->becf', xg, w_u)
    ye = jnp.einsum('becf,efd->becd', hid, w_d) * gates[..., None].astype(h.dtype)
    out = jax.vmap(lambda yb, ib: jax.ops.segment_sum(yb.reshape(-1, D), ib.reshape(-1), num_segments=S))(ye, idx)
    return out.astype(h.dtype)


def setup_inputs(seed: int = 0) -> dict:
    key = jax.random.key(seed)
    ks = jax.random.split(key, 32)
    L, D, G, P, Cg = DEPTH, D_MODEL, N_SSM_GROUPS, SSM_STATE, SSM_GROUP
    nrm = lambda k, shape, s: jax.random.normal(k, shape, jnp.float32) * s
    lam_im_init = jnp.broadcast_to(math.pi * jnp.arange(P, dtype=jnp.float32), (L, 2, G, P))
    return {
        "x": nrm(ks[0], (BATCH, SEQ, D), 1.0),
        "c": nrm(ks[1], (BATCH, D), 1.0),
        "w_mod": nrm(ks[2], (L, D, 6 * D), 0.5 * D ** -0.5),
        "b_mod": nrm(ks[3], (L, 6 * D), 0.02),
        "ln1_w": 1.0 + nrm(ks[4], (L, D), 0.02),
        "ln2_w": 1.0 + nrm(ks[5], (L, D), 0.02),
        "w_in": nrm(ks[6], (L, D, N_IN), D ** -0.5),
        "ssm_lam_re": -0.5 + nrm(ks[7], (L, 2, G, P), 0.01),
        "ssm_lam_im": lam_im_init + nrm(ks[8], (L, 2, G, P), 0.01),
        "ssm_log_dt": jax.random.uniform(ks[9], (L, 2, G), jnp.float32, math.log(DT_MIN), math.log(DT_MAX)),
        "ssm_b_re": nrm(ks[10], (L, 2, G, P, Cg), (2 * Cg) ** -0.5),
        "ssm_b_im": nrm(ks[11], (L, 2, G, P, Cg), (2 * Cg) ** -0.5),
        "ssm_c_re": nrm(ks[12], (L, 2, G, Cg, P), P ** -0.5),
        "ssm_c_im": nrm(ks[13], (L, 2, G, Cg, P), P ** -0.5),
        "ssm_d": nrm(ks[14], (L, D_SSM), 1.0),
        "w_glu": nrm(ks[15], (L, D_SSM, D_SSM), D_SSM ** -0.5),
        "b_glu": nrm(ks[16], (L, D_SSM), 0.02),
        "q_norm_w": 1.0 + nrm(ks[17], (L, HEAD_DIM), 0.02),
        "k_norm_w": 1.0 + nrm(ks[18], (L, HEAD_DIM), 0.02),
        "w_ssm_up": nrm(ks[19], (L, D_SSM, D), D_SSM ** -0.5),
        "w_attn_up": nrm(ks[20], (L, D_ATTN, D), D_ATTN ** -0.5),
        "w_out": nrm(ks[21], (L, D, D), D ** -0.5),
        "w_router": nrm(ks[22], (L, D, N_EXPERTS), D ** -0.5),
        "w_exp_gate": nrm(ks[23], (L, N_EXPERTS, D, D_FF_EXPERT), D ** -0.5),
        "w_exp_up": nrm(ks[24], (L, N_EXPERTS, D, D_FF_EXPERT), D ** -0.5),
        "w_exp_down": nrm(ks[25], (L, N_EXPERTS, D_FF_EXPERT, D), D_FF_EXPERT ** -0.5),
    }


def reference(x, c, w_mod, b_mod, ln1_w, ln2_w, w_in, ssm_lam_re, ssm_lam_im, ssm_log_dt,
              ssm_b_re, ssm_b_im, ssm_c_re, ssm_c_im, ssm_d, w_glu, b_glu, q_norm_w, k_norm_w,
              w_ssm_up, w_attn_up, w_out, w_router, w_exp_gate, w_exp_up, w_exp_down):
    tabs = axial_rope_tables(x.shape[1])
    c_act = jax.nn.silu(c)
    for l in range(DEPTH):
        mod = c_act @ w_mod[l] + b_mod[l]
        sh1, sc1, g1, sh2, sc2, g2 = jnp.split(mod, 6, axis=-1)
        h = modulate(x, ln1_w[l], sh1, sc1)
        mix = token_mixer(h, tabs, w_in[l], ssm_lam_re[l], ssm_lam_im[l], ssm_log_dt[l],
                          ssm_b_re[l], ssm_b_im[l], ssm_c_re[l], ssm_c_im[l], ssm_d[l],
                          w_glu[l], b_glu[l], q_norm_w[l], k_norm_w[l],
                          w_ssm_up[l], w_attn_up[l], w_out[l])
        x = x + g1[:, None, :] * mix
        h = modulate(x, ln2_w[l], sh2, sc2)
        x = x + g2[:, None, :] * expert_choice_moe(h, w_router[l], w_exp_gate[l], w_exp_up[l], w_exp_down[l])
    return x
```

```cpp
#include <hip/hip_runtime.h>
#include <hip/hip_cooperative_groups.h>
#include <cstdio>
#include <cstdint>
#include <utility>
namespace cg = cooperative_groups;

#ifndef ONE_LAUNCH
#define ONE_LAUNCH 0
#endif

typedef unsigned short bf16_t;
typedef unsigned v4u __attribute__((ext_vector_type(4)));
typedef unsigned v2u __attribute__((ext_vector_type(2)));
typedef float f32x4 __attribute__((ext_vector_type(4)));

constexpr int D = 1024, NB = 4, S = 4096, T = NB * S, DEPTH = 2;
constexpr int HD = 64, NQH = 8, NKVH = 2, DATT = 512, DKV = 128;
constexpr int DSSM = 512, NG = 32, NP = 64;
constexpr int NE = 16, CAP = 512, DFF = 2048;
constexpr int NIN = 3328;
constexpr int CL = 64, NCH = S / CL;
constexpr int UXW = CL * 16 + 256;
constexpr float EPS = 1e-6f;
constexpr float QSCALE = 0.125f * 1.4426950408889634f;
constexpr int NTHREADS = 512, NWAVES = 8;
constexpr int LDS_BYTES = 147456;

constexpr size_t MiB = 1u << 20;
constexpr size_t WS_CTL = 0;
constexpr size_t WS_MOD = 1 * MiB;
constexpr size_t WS_WIN = 2 * MiB;
constexpr size_t WS_WGLU = 15 * MiB;
constexpr size_t WS_WSU = 16 * MiB;
constexpr size_t WS_WAU = 18 * MiB;
constexpr size_t WS_WOUT = 20 * MiB;
constexpr size_t WS_WGU = 24 * MiB;
constexpr size_t WS_WD = 280 * MiB;
constexpr size_t WS_SSMM = 408 * MiB;
constexpr size_t WS_SSMS = 568 * MiB;
constexpr size_t WS_SSMA = 600 * MiB;
constexpr size_t WS_H = 604 * MiB;
constexpr size_t WS_AFF = 636 * MiB;
constexpr size_t WS_IDX = 637 * MiB;
constexpr size_t WS_GATE = 637 * MiB + 128 * 1024;
constexpr size_t WS_INV = 637 * MiB + 256 * 1024;
constexpr size_t WS_STG = 640 * MiB;
constexpr size_t WS_UX = WS_STG;
constexpr size_t WS_QB = WS_STG + 20 * MiB;
constexpr size_t WS_KB = WS_STG + 36 * MiB;
constexpr size_t WS_VB = WS_STG + 40 * MiB;
constexpr size_t WS_GS = WS_STG + 44 * MiB;
constexpr size_t WS_GA = WS_STG + 76 * MiB;
constexpr size_t WS_AO = WS_STG + 108 * MiB;
constexpr size_t WS_SLOC = WS_STG + 124 * MiB;
constexpr size_t WS_Z = WS_STG + 132 * MiB;
constexpr size_t WS_SO = WS_STG + 148 * MiB;
constexpr size_t WS_MG = WS_STG + 164 * MiB;
constexpr size_t WS_PQK = WS_STG + 196 * MiB;
constexpr size_t WS_YP = WS_STG + 236 * MiB;
constexpr size_t WS_XG = WS_STG;
constexpr size_t WS_HID = WS_STG + 64 * MiB;
constexpr size_t WS_YE = WS_STG + 192 * MiB;
constexpr size_t WS_END = WS_STG + 300 * MiB;

struct Params {
    const float *x, *c, *w_mod, *b_mod, *ln1_w, *ln2_w, *w_in, *lam_re, *lam_im, *log_dt, *b_re, *b_im, *c_re, *c_im, *ssm_d,
        *w_glu, *b_glu, *q_norm_w, *k_norm_w, *w_ssm_up, *w_attn_up, *w_out, *w_router, *w_eg, *w_eu, *w_ed;
    float* out;
    unsigned char* ws;
};

__device__ __forceinline__ int opaque_tid() { int t = threadIdx.x; asm volatile("" : "+v"(t)); return t; }
__device__ __forceinline__ float bf2f(bf16_t v) { return __uint_as_float(((unsigned)v) << 16); }
__device__ __forceinline__ unsigned f2bf(float f) { unsigned u = __float_as_uint(f); return (u + 0x7fffu + ((u >> 16) & 1u)) >> 16; }
__device__ __forceinline__ unsigned pk2(float lo, float hi) { return f2bf(lo) | (f2bf(hi) << 16); }
__device__ __forceinline__ float lo16(unsigned w) { return __uint_as_float(w << 16); }
__device__ __forceinline__ float hi16(unsigned w) { return __uint_as_float(w & 0xffff0000u); }
__device__ __forceinline__ float wave_sum(float v) {
#pragma unroll
    for (int o = 32; o > 0; o >>= 1) v += __shfl_xor(v, o);
    return v;
}
__device__ __forceinline__ float sigmoidf_(float v) { return 1.0f / (1.0f + __expf(-v)); }
__device__ __forceinline__ float siluf_(float v) { return v / (1.0f + __expf(-v)); }
__device__ __forceinline__ float gelu_tanh(float y) { const float u = 0.7978845608028654f * (y + 0.044715f * y * y * y); return 0.5f * y * (1.0f + tanhf(u)); }

__device__ __forceinline__ void pro_mod(const Params& p, float* lds) {
    const int tid = opaque_tid(), w = tid >> 6, lane = tid & 63;
    float* mod = (float*)(p.ws + WS_MOD);
    for (int it = blockIdx.x; it < 192; it += gridDim.x) {
        const int l = it / 96, n0 = (it % 96) * 64;
        const float* W = p.w_mod + (size_t)l * 1024 * 6144;
        float a0 = 0.f, a1 = 0.f, a2 = 0.f, a3 = 0.f;
        for (int kk = 0; kk < 128; ++kk) {
            const int k = w * 128 + kk;
            const float wv = W[(size_t)k * 6144 + n0 + lane];
            a0 += siluf_(p.c[k]) * wv; a1 += siluf_(p.c[1024 + k]) * wv; a2 += siluf_(p.c[2048 + k]) * wv; a3 += siluf_(p.c[3072 + k]) * wv;
        }
        lds[(w * 4 + 0) * 64 + lane] = a0; lds[(w * 4 + 1) * 64 + lane] = a1; lds[(w * 4 + 2) * 64 + lane] = a2; lds[(w * 4 + 3) * 64 + lane] = a3;
        __syncthreads();
        if (tid < 256) {
            const int b = tid >> 6; float s = 0.f;
            for (int w2 = 0; w2 < 8; ++w2) s += lds[(w2 * 4 + b) * 64 + lane];
            mod[(size_t)(l * 4 + b) * 6144 + n0 + lane] = s + p.b_mod[l * 6144 + n0 + lane];
        }
        __syncthreads();
    }
}
__device__ __forceinline__ void transpose_item(const float* W, int K, int N, bf16_t* WT, int k0, int n0, int drow0, float* scr, int lane) {
#pragma unroll 8
    for (int i = 0; i < 32; ++i) { const int kk = 2 * i + (lane >> 5); scr[kk * 33 + (lane & 31)] = W[(size_t)(k0 + kk) * N + n0 + (lane & 31)]; }
    asm volatile("s_waitcnt lgkmcnt(0)" ::: "memory");
    const int c = lane & 7;
#pragma unroll
    for (int j = 0; j < 4; ++j) {
        const int n = (lane >> 3) + 8 * j; const float* s = scr + (8 * c) * 33 + n;
        v4u o; o.x = pk2(s[0 * 33], s[1 * 33]); o.y = pk2(s[2 * 33], s[3 * 33]); o.z = pk2(s[4 * 33], s[5 * 33]); o.w = pk2(s[6 * 33], s[7 * 33]);
        *(v4u*)(WT + (size_t)(drow0 + n) * K + k0 + 8 * c) = o;
    }
    asm volatile("s_waitcnt lgkmcnt(0)" ::: "memory");
}
__device__ __forceinline__ void pro_weights(const Params& p, float* lds) {
    const int tid = opaque_tid(), w = tid >> 6, lane = tid & 63;
    float* scr = lds + w * (64 * 33 + 16);
    const int gw = blockIdx.x * NWAVES + w, NGW = gridDim.x * NWAVES;
    constexpr int PER_L = 2816 + 16 * 3072;
    for (int it = gw; it < 2 * PER_L; it += NGW) {
        const int l = it / PER_L; int r = it % PER_L;
        const float* W; int K, N; bf16_t* WT; int mode = 0;
        if (r < 1664) { W = p.w_in + (size_t)l * 1024 * NIN; K = 1024; N = NIN; WT = (bf16_t*)(p.ws + WS_WIN) + (size_t)l * NIN * 1024; }
        else if (r < 1792) { r -= 1664; W = p.w_glu + (size_t)l * 512 * 512; K = 512; N = 512; WT = (bf16_t*)(p.ws + WS_WGLU) + (size_t)l * 512 * 512; }
        else if (r < 2048) { r -= 1792; W = p.w_ssm_up + (size_t)l * 512 * 1024; K = 512; N = 1024; WT = (bf16_t*)(p.ws + WS_WSU) + (size_t)l * 1024 * 512; }
        else if (r < 2304) { r -= 2048; W = p.w_attn_up + (size_t)l * 512 * 1024; K = 512; N = 1024; WT = (bf16_t*)(p.ws + WS_WAU) + (size_t)l * 1024 * 512; }
        else if (r < 2816) { r -= 2304; W = p.w_out + (size_t)l * 1024 * 1024; K = 1024; N = 1024; WT = (bf16_t*)(p.ws + WS_WOUT) + (size_t)l * 1024 * 1024; }
        else {
            r -= 2816; const int e = r / 3072, q = r % 3072, which = q / 1024; r = q % 1024;
            const size_t le = (size_t)l * 16 + e;
            if (which == 0) { W = p.w_eg + le * 1024 * 2048; K = 1024; N = 2048; WT = (bf16_t*)(p.ws + WS_WGU) + le * 4096 * 1024; mode = 1; }
            else if (which == 1) { W = p.w_eu + le * 1024 * 2048; K = 1024; N = 2048; WT = (bf16_t*)(p.ws + WS_WGU) + le * 4096 * 1024; mode = 2; }
            else { W = p.w_ed + le * 2048 * 1024; K = 2048; N = 1024; WT = (bf16_t*)(p.ws + WS_WD) + le * 1024 * 2048; }
        }
        const int nblk = N / 32, kb = r / nblk, nb = r % nblk, k0 = 64 * kb, n0 = 32 * nb;
        int drow0 = n0;
        if (mode) drow0 = (n0 / 128) * 256 + (n0 % 128) + (mode == 2 ? 128 : 0);
        transpose_item(W, K, N, WT, k0, n0, drow0, scr, lane);
    }
}

template <bool ROUTER>
__device__ __forceinline__ void phase_norm(const Params& p, int l, const float* xin) {
    const int tid = opaque_tid(), w = tid >> 6, lane = tid & 63;
    const int gw = blockIdx.x * NWAVES + w, NGW = gridDim.x * NWAVES;
    const float* lnw = (ROUTER ? p.ln2_w : p.ln1_w) + l * 1024;
    const float* mod = (const float*)(p.ws + WS_MOD);
    bf16_t* H = (bf16_t*)(p.ws + WS_H);
    float* AFF = (float*)(p.ws + WS_AFF);
    const float* wr = p.w_router + (size_t)l * 1024 * 16;
    for (int m = gw; m < T; m += NGW) {
        const int b = m >> 12;
        const float* modb = mod + (size_t)(l * 4 + b) * 6144 + (ROUTER ? 3072 : 0);
        f32x4 v[4]; float ss = 0.f;
#pragma unroll
        for (int j = 0; j < 4; ++j) { v[j] = *(const f32x4*)(xin + (size_t)m * 1024 + j * 256 + lane * 4); ss += v[j].x * v[j].x + v[j].y * v[j].y + v[j].z * v[j].z + v[j].w * v[j].w; }
        const float r = rsqrtf(wave_sum(ss) * (1.0f / 1024.0f) + EPS);
        float lg[16];
        if (ROUTER) {
#pragma unroll
            for (int e = 0; e < 16; ++e) lg[e] = 0.f;
        }
#pragma unroll
        for (int j = 0; j < 4; ++j) {
            const int col = j * 256 + lane * 4;
            const f32x4 w4 = *(const f32x4*)(lnw + col), sh = *(const f32x4*)(modb + col), sc = *(const f32x4*)(modb + 1024 + col);
            f32x4 h;
            h.x = v[j].x * r * w4.x * (1.f + sc.x) + sh.x; h.y = v[j].y * r * w4.y * (1.f + sc.y) + sh.y;
            h.z = v[j].z * r * w4.z * (1.f + sc.z) + sh.z; h.w = v[j].w * r * w4.w * (1.f + sc.w) + sh.w;
            v2u o; o.x = pk2(h.x, h.y); o.y = pk2(h.z, h.w);
            *(v2u*)(H + (size_t)m * 1024 + col) = o;
            if (ROUTER) {
                const float hv[4] = {h.x, h.y, h.z, h.w};
#pragma unroll
                for (int i = 0; i < 4; ++i) {
                    const f32x4* wp = (const f32x4*)(wr + (size_t)(col + i) * 16);
#pragma unroll
                    for (int q = 0; q < 4; ++q) { const f32x4 ww = wp[q]; lg[q * 4 + 0] += hv[i] * ww.x; lg[q * 4 + 1] += hv[i] * ww.y; lg[q * 4 + 2] += hv[i] * ww.z; lg[q * 4 + 3] += hv[i] * ww.w; }
                }
            }
        }
        if (ROUTER) {
            float mx = -1e30f;
#pragma unroll
            for (int e = 0; e < 16; ++e) { lg[e] = wave_sum(lg[e]); mx = fmaxf(mx, lg[e]); }
            float sum = 0.f;
#pragma unroll
            for (int e = 0; e < 16; ++e) { lg[e] = expf(lg[e] - mx); sum += lg[e]; }
            float mine = 0.f;
#pragma unroll
            for (int e = 0; e < 16; ++e) if (lane == e) mine = lg[e] / sum;
            if (lane < 16) AFF[(size_t)(b * 16 + lane) * 4096 + (m & 4095)] = mine;
        }
    }
}

template <class Epi>
__device__ __forceinline__ void gemm_naive(const bf16_t* A, int lda, size_t strideA, const bf16_t* Bt, int ldb, size_t strideB, int M, int N, int K, int ngroups, const Epi& epi, float* lds) {
    const int tid = opaque_tid(), ty = tid >> 4, tx = tid & 15;
    float* As = lds;
    float* Bs = lds + 16 * 132;
    const int ntm = M / 128, ntn = N / 256, per_g = ntm * ntn, total = ngroups * per_g;
    for (int tile = blockIdx.x; tile < total; tile += gridDim.x) {
        const int g = tile / per_g, r = tile % per_g, m0 = (r / ntn) * 128, n0 = (r % ntn) * 256;
        const bf16_t* Ag = A + (size_t)g * strideA; const bf16_t* Bg = Bt + (size_t)g * strideB;
        float acc[4][16];
#pragma unroll
        for (int i = 0; i < 4; ++i)
#pragma unroll
            for (int j = 0; j < 16; ++j) acc[i][j] = 0.f;
        for (int k0 = 0; k0 < K; k0 += 16) {
            __syncthreads();
            {
                const int row = tid >> 2, k4 = (tid & 3) * 4;
                const v2u a = *(const v2u*)(Ag + (size_t)(m0 + row) * lda + k0 + k4);
                As[(k4 + 0) * 132 + row] = lo16(a.x); As[(k4 + 1) * 132 + row] = hi16(a.x); As[(k4 + 2) * 132 + row] = lo16(a.y); As[(k4 + 3) * 132 + row] = hi16(a.y);
                const int brow = tid >> 1, k8 = (tid & 1) * 8;
                const v4u b = *(const v4u*)(Bg + (size_t)(n0 + brow) * ldb + k0 + k8);
                Bs[(k8 + 0) * 260 + brow] = lo16(b.x); Bs[(k8 + 1) * 260 + brow] = hi16(b.x); Bs[(k8 + 2) * 260 + brow] = lo16(b.y); Bs[(k8 + 3) * 260 + brow] = hi16(b.y);
                Bs[(k8 + 4) * 260 + brow] = lo16(b.z); Bs[(k8 + 5) * 260 + brow] = hi16(b.z); Bs[(k8 + 6) * 260 + brow] = lo16(b.w); Bs[(k8 + 7) * 260 + brow] = hi16(b.w);
            }
            __syncthreads();
#pragma unroll
            for (int k = 0; k < 16; ++k) {
                const f32x4 a = *(const f32x4*)(As + k * 132 + ty * 4);
                const f32x4 b0 = *(const f32x4*)(Bs + k * 260 + tx * 8), b1 = *(const f32x4*)(Bs + k * 260 + tx * 8 + 4);
                const f32x4 b2 = *(const f32x4*)(Bs + k * 260 + 128 + tx * 8), b3 = *(const f32x4*)(Bs + k * 260 + 128 + tx * 8 + 4);
                const float av[4] = {a.x, a.y, a.z, a.w};
                const float bv[16] = {b0.x, b0.y, b0.z, b0.w, b1.x, b1.y, b1.z, b1.w, b2.x, b2.y, b2.z, b2.w, b3.x, b3.y, b3.z, b3.w};
#pragma unroll
                for (int i = 0; i < 4; ++i)
#pragma unroll
                    for (int j = 0; j < 16; ++j) acc[i][j] += av[i] * bv[j];
            }
        }
#pragma unroll
        for (int i = 0; i < 4; ++i)
#pragma unroll
            for (int j = 0; j < 8; ++j) epi(g, m0 + ty * 4 + i, n0, tx * 8 + j, acc[i][j], acc[i][8 + j]);
    }
}

struct EpiInProj {
    bf16_t *UX, *VB, *GS, *GA; float* PQK;
    __device__ __forceinline__ void one(int m, int n, float v) const {
        if (n < 512) { const int b = m >> 12, t = m & 4095, g = n >> 4; UX[((size_t)g * 256 + b * 64 + (t >> 6)) * UXW + (t & 63) * 16 + (n & 15)] = (bf16_t)f2bf(v); }
        else if (n < 1152) PQK[(size_t)m * 640 + (n - 512)] = v;
        else if (n < 1280) VB[(size_t)m * 128 + (n - 1152)] = (bf16_t)f2bf(v);
        else if (n < 2304) GS[(size_t)m * 1024 + (n - 1280)] = (bf16_t)f2bf(sigmoidf_(v));
        else GA[(size_t)m * 1024 + (n - 2304)] = (bf16_t)f2bf(sigmoidf_(v));
    }
    __device__ __forceinline__ void operator()(int, int m, int n0, int j, float v0, float v1) const { one(m, n0 + j, v0); one(m, n0 + 128 + j, v1); }
};
struct EpiGlu {
    const bf16_t* Z; bf16_t* SO; const float* bias;
    __device__ __forceinline__ void one(int m, int n, float v) const { const float z = bf2f(Z[(size_t)m * 512 + n]); SO[(size_t)m * 512 + n] = (bf16_t)f2bf(z * sigmoidf_(v + bias[n])); }
    __device__ __forceinline__ void operator()(int, int m, int n0, int j, float v0, float v1) const { one(m, n0 + j, v0); one(m, n0 + 128 + j, v1); }
};
template <bool ADD> struct EpiUp {
    const bf16_t* G; bf16_t* MG;
    __device__ __forceinline__ void one(int m, int n, float v) const {
        const size_t i = (size_t)m * 1024 + n; float r = bf2f(G[i]) * v; if (ADD) r += bf2f(MG[i]); MG[i] = (bf16_t)f2bf(r);
    }
    __device__ __forceinline__ void operator()(int, int m, int n0, int j, float v0, float v1) const { one(m, n0 + j, v0); one(m, n0 + 128 + j, v1); }
};
struct EpiOut {
    const float* xin; float* XR; const float* mod_l;
    __device__ __forceinline__ void one(int m, int n, float v) const { const int b = m >> 12; const size_t i = (size_t)m * 1024 + n; XR[i] = xin[i] + mod_l[(size_t)b * 6144 + 2048 + n] * v; }
    __device__ __forceinline__ void operator()(int, int m, int n0, int j, float v0, float v1) const { one(m, n0 + j, v0); one(m, n0 + 128 + j, v1); }
};
struct EpiMoe1 {
    bf16_t* HID;
    __device__ __forceinline__ void operator()(int g, int m, int n0, int j, float v0, float v1) const { HID[((size_t)g * 2048 + m) * 2048 + (n0 >> 1) + j] = (bf16_t)f2bf(siluf_(v0) * v1); }
};
struct EpiMoe2 {
    bf16_t* YE; const float* GATE;
    __device__ __forceinline__ void one(int g, int m, int n, float v) const { const int b = m >> 9, c = m & 511; YE[((size_t)g * 2048 + m) * 1024 + n] = (bf16_t)f2bf(v * GATE[(size_t)(b * 16 + g) * 512 + c]); }
    __device__ __forceinline__ void operator()(int g, int m, int n0, int j, float v0, float v1) const { one(g, m, n0 + j, v0); one(g, m, n0 + 128 + j, v1); }
};

__device__ __forceinline__ void phase_qkpost(const Params& p, int l) {
    const float* PQK = (const float*)(p.ws + WS_PQK);
    bf16_t* QB = (bf16_t*)(p.ws + WS_QB); bf16_t* KB = (bf16_t*)(p.ws + WS_KB);
    const int total = T * 10;
    for (int i = blockIdx.x * NTHREADS + opaque_tid(); i < total; i += gridDim.x * NTHREADS) {
        const int m = i / 10, j = i % 10, t = m & 4095;
        const float* src = PQK + (size_t)m * 640 + j * 64;
        const float* nw = (j < 8 ? p.q_norm_w : p.k_norm_w) + l * 64;
        float xv[64]; float ss = 0.f;
#pragma unroll
        for (int d = 0; d < 64; ++d) { xv[d] = src[d]; ss += xv[d] * xv[d]; }
        const float r = rsqrtf(ss * (1.0f / 64.0f) + EPS);
#pragma unroll
        for (int d = 0; d < 64; ++d) xv[d] = xv[d] * r * nw[d];
        const float posr = (float)(t >> 6), posc = (float)(t & 63);
        const float osc = (j < 8) ? QSCALE : 1.0f;
        bf16_t* dst = (j < 8) ? (QB + (size_t)m * 512 + j * 64) : (KB + (size_t)m * 128 + (j - 8) * 64);
#pragma unroll
        for (int d = 0; d < 16; ++d) {
            const float inv = exp2f(-(float)d * (13.287712379549449f / 16.0f));
            float sr, cr, sc, cc; sincosf(posr * inv, &sr, &cr); sincosf(posc * inv, &sc, &cc);
            const float a1 = xv[d], a2 = xv[16 + d], b1 = xv[32 + d], b2 = xv[48 + d];
            dst[d] = (bf16_t)f2bf((a1 * cr - a2 * sr) * osc); dst[16 + d] = (bf16_t)f2bf((a1 * sr + a2 * cr) * osc);
            dst[32 + d] = (bf16_t)f2bf((b1 * cc - b2 * sc) * osc); dst[48 + d] = (bf16_t)f2bf((b1 * sc + b2 * cc) * osc);
        }
    }
}

__device__ __forceinline__ void phase_attn_naive(const Params& p, float* lds) {
    const int tid = opaque_tid();
    const bf16_t* QB = (const bf16_t*)(p.ws + WS_QB); const bf16_t* KB = (const bf16_t*)(p.ws + WS_KB); const bf16_t* VB = (const bf16_t*)(p.ws + WS_VB);
    bf16_t* AO = (bf16_t*)(p.ws + WS_AO);
    float* Ks = lds; float* Vs = lds + 64 * 64;
    for (int it = blockIdx.x; it < 256; it += gridDim.x) {
        const int b = it >> 6, hq = (it >> 3) & 7, ch = it & 7, hkv = hq >> 2;
        const int m = b * 4096 + ch * 512 + tid;
        float q[64], o[64];
        {
            const v4u* qp = (const v4u*)(QB + (size_t)m * 512 + hq * 64);
#pragma unroll
            for (int i = 0; i < 8; ++i) { const v4u w = qp[i]; q[i * 8 + 0] = lo16(w.x); q[i * 8 + 1] = hi16(w.x); q[i * 8 + 2] = lo16(w.y); q[i * 8 + 3] = hi16(w.y); q[i * 8 + 4] = lo16(w.z); q[i * 8 + 5] = hi16(w.z); q[i * 8 + 6] = lo16(w.w); q[i * 8 + 7] = hi16(w.w); }
        }
#pragma unroll
        for (int d = 0; d < 64; ++d) o[d] = 0.f;
        float mx = -1e30f, lsum = 0.f;
        for (int kt = 0; kt < 64; ++kt) {
            __syncthreads();
            {
                const int key = tid >> 3, d8 = (tid & 7) * 8;
                const size_t off = (size_t)(b * 4096 + kt * 64 + key) * 128 + hkv * 64 + d8;
                const v4u kw = *(const v4u*)(KB + off), vw = *(const v4u*)(VB + off);
                float* kd = Ks + key * 64 + d8; float* vd = Vs + key * 64 + d8;
                kd[0] = lo16(kw.x); kd[1] = hi16(kw.x); kd[2] = lo16(kw.y); kd[3] = hi16(kw.y); kd[4] = lo16(kw.z); kd[5] = hi16(kw.z); kd[6] = lo16(kw.w); kd[7] = hi16(kw.w);
                vd[0] = lo16(vw.x); vd[1] = hi16(vw.x); vd[2] = lo16(vw.y); vd[3] = hi16(vw.y); vd[4] = lo16(vw.z); vd[5] = hi16(vw.z); vd[6] = lo16(vw.w); vd[7] = hi16(vw.w);
            }
            __syncthreads();
#pragma unroll 1
            for (int j = 0; j < 64; ++j) {
                float a0 = 0.f, a1 = 0.f; const float* kr = Ks + j * 64;
#pragma unroll
                for (int d = 0; d < 64; d += 8) {
                    const f32x4 kv = *(const f32x4*)(kr + d), kw = *(const f32x4*)(kr + d + 4);
                    a0 += q[d] * kv.x + q[d + 1] * kv.y + q[d + 2] * kv.z + q[d + 3] * kv.w; a1 += q[d + 4] * kw.x + q[d + 5] * kw.y + q[d + 6] * kw.z + q[d + 7] * kw.w;
                }
                const float sc = a0 + a1;
                if (sc > mx) {
                    const float corr = exp2f(mx - sc); lsum *= corr;
#pragma unroll
                    for (int d = 0; d < 64; ++d) o[d] *= corr;
                    mx = sc;
                }
                const float pj = exp2f(sc - mx); lsum += pj; const float* vr = Vs + j * 64;
#pragma unroll
                for (int d = 0; d < 64; d += 4) { const f32x4 vv = *(const f32x4*)(vr + d); o[d] += pj * vv.x; o[d + 1] += pj * vv.y; o[d + 2] += pj * vv.z; o[d + 3] += pj * vv.w; }
            }
        }
        const float il = 1.0f / lsum;
        v4u* op = (v4u*)(AO + (size_t)m * 512 + hq * 64);
#pragma unroll
        for (int i = 0; i < 8; ++i) { v4u w; w.x = pk2(o[i * 8] * il, o[i * 8 + 1] * il); w.y = pk2(o[i * 8 + 2] * il, o[i * 8 + 3] * il); w.z = pk2(o[i * 8 + 4] * il, o[i * 8 + 5] * il); w.w = pk2(o[i * 8 + 6] * il, o[i * 8 + 7] * il); op[i] = w; }
    }
}

__device__ __forceinline__ void phase_ssm_naive(const Params& p, int l) {
    const int tid = opaque_tid(), w = tid >> 6, lane = tid & 63;
    const int gw = blockIdx.x * NWAVES + w, NGW = gridDim.x * NWAVES;
    const bf16_t* UX = (const bf16_t*)(p.ws + WS_UX);
    float* YP = (float*)(p.ws + WS_YP);
    for (int it = gw; it < 256; it += NGW) {
        const int b = it >> 6, g = (it >> 1) & 31, dir = it & 1;
        const size_t gi = (size_t)(l * 2 + dir) * 32 + g, pi = gi * 64 + lane;
        const float lr = p.lam_re[pi], li = p.lam_im[pi], dt = expf(p.log_dt[gi]);
        const float mag = expf(lr * dt), ar = mag * cosf(li * dt), ai = mag * sinf(li * dt);
        const float nr = ar - 1.0f, ni = ai, den = lr * lr + li * li;
        const float fr = (nr * lr + ni * li) / den, fi = (ni * lr - nr * li) / den;
        float bbr[16], bbi[16], cr[16], ci[16];
#pragma unroll
        for (int c = 0; c < 16; ++c) {
            const float br = p.b_re[pi * 16 + c], bi = p.b_im[pi * 16 + c];
            bbr[c] = fr * br - fi * bi; bbi[c] = fr * bi + fi * br;
            cr[c] = p.c_re[(gi * 16 + c) * 64 + lane]; ci[c] = p.c_im[(gi * 16 + c) * 64 + lane];
        }
        float xr = 0.f, xi = 0.f;
        const bf16_t* ub = UX + ((size_t)g * 256 + b * 64) * UXW;
        int t = dir ? 4095 : 0;
        const v4u* up = (const v4u*)(ub + (size_t)(t >> 6) * UXW + (t & 63) * 16);
        v4u n0 = up[0], n1 = up[1];
        for (int s = 0; s < 4096; ++s) {
            const v4u u0 = n0, u1 = n1;
            const int tn = dir ? (t > 0 ? t - 1 : 0) : (t < 4095 ? t + 1 : 4095);
            const v4u* upn = (const v4u*)(ub + (size_t)(tn >> 6) * UXW + (tn & 63) * 16);
            n0 = upn[0]; n1 = upn[1];
            const float u[16] = {lo16(u0.x), hi16(u0.x), lo16(u0.y), hi16(u0.y), lo16(u0.z), hi16(u0.z), lo16(u0.w), hi16(u0.w),
                                 lo16(u1.x), hi16(u1.x), lo16(u1.y), hi16(u1.y), lo16(u1.z), hi16(u1.z), lo16(u1.w), hi16(u1.w)};
            float bur = 0.f, bui = 0.f;
#pragma unroll
            for (int c = 0; c < 16; ++c) { bur += bbr[c] * u[c]; bui += bbi[c] * u[c]; }
            const float nxr = ar * xr - ai * xi + bur, nxi = ar * xi + ai * xr + bui; xr = nxr; xi = nxi;
            float mine = 0.f;
#pragma unroll
            for (int c = 0; c < 16; ++c) { float v = cr[c] * xr - ci[c] * xi; v = wave_sum(v); if (lane == c) mine = v; }
            if (lane < 16) YP[((size_t)dir * T + b * 4096 + t) * 512 + g * 16 + lane] = mine;
            t = tn;
        }
    }
}
__device__ __forceinline__ void phase_ssmpost_naive(const Params& p, int l) {
    const bf16_t* UX = (const bf16_t*)(p.ws + WS_UX); const float* YP = (const float*)(p.ws + WS_YP); bf16_t* Z = (bf16_t*)(p.ws + WS_Z);
    const int total = T * 512;
    for (int i = blockIdx.x * NTHREADS + opaque_tid(); i < total; i += gridDim.x * NTHREADS) {
        const int m = i >> 9, ch = i & 511, b = m >> 12, t = m & 4095, g = ch >> 4, co = ch & 15;
        const float u = bf2f(UX[((size_t)g * 256 + b * 64 + (t >> 6)) * UXW + (t & 63) * 16 + co]);
        const float y = YP[(size_t)m * 512 + ch] + YP[((size_t)T + m) * 512 + ch] + p.ssm_d[l * 512 + ch] * u;
        Z[(size_t)m * 512 + ch] = (bf16_t)f2bf(gelu_tanh(y));
    }
}

__device__ __forceinline__ void phase_topk(const Params& p, float* lds) {
    const int tid = opaque_tid();
    const float* AFF = (const float*)(p.ws + WS_AFF);
    int* IDX = (int*)(p.ws + WS_IDX); float* GATE = (float*)(p.ws + WS_GATE); int* INV = (int*)(p.ws + WS_INV);
    for (int it = blockIdx.x; it < 256; it += gridDim.x) {
        const int be = it >> 2, qd = it & 3, b = be >> 4, e = be & 15;
        __syncthreads();
        for (int i = tid; i < 4096; i += NTHREADS) lds[i] = AFF[(size_t)be * 4096 + i];
        __syncthreads();
#pragma unroll 1
        for (int r = 0; r < 2; ++r) {
            const int t = qd * 1024 + r * 512 + tid; const float v = lds[t]; int cnt = 0;
            for (int j = 0; j < 4096; j += 4) {
                const f32x4 vj = *(const f32x4*)(lds + j);
                cnt += (vj.x > v || (vj.x == v && j < t)) ? 1 : 0; cnt += (vj.y > v || (vj.y == v && j + 1 < t)) ? 1 : 0;
                cnt += (vj.z > v || (vj.z == v && j + 2 < t)) ? 1 : 0; cnt += (vj.w > v || (vj.w == v && j + 3 < t)) ? 1 : 0;
            }
            if (cnt < CAP) { IDX[be * 512 + cnt] = t; GATE[be * 512 + cnt] = v; INV[((size_t)b * 4096 + t) * 16 + e] = cnt; }
            else INV[((size_t)b * 4096 + t) * 16 + e] = -1;
        }
    }
}
__device__ __forceinline__ void phase_gather(const Params& p) {
    const int tid = opaque_tid(), w = tid >> 6, lane = tid & 63;
    const int gw = blockIdx.x * NWAVES + w, NGW = gridDim.x * NWAVES;
    const bf16_t* H = (const bf16_t*)(p.ws + WS_H); bf16_t* XG = (bf16_t*)(p.ws + WS_XG); const int* IDX = (const int*)(p.ws + WS_IDX);
    for (int slot = gw; slot < NE * 2048; slot += NGW) {
        const int e = slot >> 11, r = slot & 2047, b = r >> 9, c = r & 511;
        const int tok = IDX[(b * 16 + e) * 512 + c];
        const v4u* src = (const v4u*)(H + ((size_t)b * 4096 + tok) * 1024); v4u* dst = (v4u*)(XG + (size_t)slot * 1024);
        dst[lane] = src[lane]; dst[lane + 64] = src[lane + 64];
    }
}
__device__ __forceinline__ void phase_combine(const Params& p, int l) {
    const int tid = opaque_tid(), w = tid >> 6, lane = tid & 63;
    const int gw = blockIdx.x * NWAVES + w, NGW = gridDim.x * NWAVES;
    const bf16_t* YE = (const bf16_t*)(p.ws + WS_YE); const int* INV = (const int*)(p.ws + WS_INV);
    const float* mod = (const float*)(p.ws + WS_MOD);
    float* XR = p.out;
    for (int m = gw; m < T; m += NGW) {
        const int b = m >> 12;
        float acc[16];
#pragma unroll
        for (int i = 0; i < 16; ++i) acc[i] = 0.f;
        for (int e = 0; e < 16; ++e) {
            const int c = INV[(size_t)m * 16 + e];
            if (c >= 0) {
                const bf16_t* row = YE + ((size_t)e * 2048 + b * 512 + c) * 1024;
#pragma unroll
                for (int j = 0; j < 4; ++j) { const v2u wv = *(const v2u*)(row + j * 256 + lane * 4); acc[j * 4] += lo16(wv.x); acc[j * 4 + 1] += hi16(wv.x); acc[j * 4 + 2] += lo16(wv.y); acc[j * 4 + 3] += hi16(wv.y); }
            }
        }
        const float* g2 = mod + (size_t)(l * 4 + b) * 6144 + 5120;
#pragma unroll
        for (int j = 0; j < 4; ++j) {
            const int col = j * 256 + lane * 4;
            f32x4 xv = *(const f32x4*)(XR + (size_t)m * 1024 + col); const f32x4 gv = *(const f32x4*)(g2 + col);
            xv.x += gv.x * acc[j * 4]; xv.y += gv.y * acc[j * 4 + 1]; xv.z += gv.z * acc[j * 4 + 2]; xv.w += gv.w * acc[j * 4 + 3];
            *(f32x4*)(XR + (size_t)m * 1024 + col) = xv;
        }
    }
}

enum { PH_NORM1 = 0, PH_INPROJ, PH_QKPOST, PH_ATTN, PH_SSM, PH_SSMPOST, PH_GLU, PH_UP1, PH_UP2, PH_OUT, PH_NORM2, PH_TOPK, PH_GATHER, PH_MOE1, PH_MOE2, PH_COMBINE, PH_PER_LAYER, PH_PRO };

template <int K>
__device__ __forceinline__ void run_phase(const Params& p, int l, float* lds) {
    unsigned char* ws = p.ws;
    const float* xin = l == 0 ? p.x : p.out;
    const float* mod_l = (const float*)(ws + WS_MOD) + (size_t)l * 4 * 6144;
    if constexpr (K == PH_NORM1) phase_norm<false>(p, l, xin);
    else if constexpr (K == PH_INPROJ) {
        EpiInProj e{(bf16_t*)(ws + WS_UX), (bf16_t*)(ws + WS_VB), (bf16_t*)(ws + WS_GS), (bf16_t*)(ws + WS_GA), (float*)(ws + WS_PQK)};
        gemm_naive((const bf16_t*)(ws + WS_H), 1024, 0, (const bf16_t*)(ws + WS_WIN) + (size_t)l * NIN * 1024, 1024, 0, T, NIN, 1024, 1, e, lds);
    }
    else if constexpr (K == PH_QKPOST) phase_qkpost(p, l);
    else if constexpr (K == PH_ATTN) phase_attn_naive(p, lds);
    else if constexpr (K == PH_SSM) phase_ssm_naive(p, l);
    else if constexpr (K == PH_SSMPOST) phase_ssmpost_naive(p, l);
    else if constexpr (K == PH_GLU) {
        EpiGlu e{(const bf16_t*)(ws + WS_Z), (bf16_t*)(ws + WS_SO), p.b_glu + l * 512};
        gemm_naive((const bf16_t*)(ws + WS_Z), 512, 0, (const bf16_t*)(ws + WS_WGLU) + (size_t)l * 512 * 512, 512, 0, T, 512, 512, 1, e, lds);
    }
    else if constexpr (K == PH_UP1) {
        EpiUp<false> e{(const bf16_t*)(ws + WS_GS), (bf16_t*)(ws + WS_MG)};
        gemm_naive((const bf16_t*)(ws + WS_SO), 512, 0, (const bf16_t*)(ws + WS_WSU) + (size_t)l * 1024 * 512, 512, 0, T, 1024, 512, 1, e, lds);
    }
    else if constexpr (K == PH_UP2) {
        EpiUp<true> e{(const bf16_t*)(ws + WS_GA), (bf16_t*)(ws + WS_MG)};
        gemm_naive((const bf16_t*)(ws + WS_AO), 512, 0, (const bf16_t*)(ws + WS_WAU) + (size_t)l * 1024 * 512, 512, 0, T, 1024, 512, 1, e, lds);
    }
    else if constexpr (K == PH_OUT) {
        EpiOut e{xin, p.out, mod_l};
        gemm_naive((const bf16_t*)(ws + WS_MG), 1024, 0, (const bf16_t*)(ws + WS_WOUT) + (size_t)l * 1024 * 1024, 1024, 0, T, 1024, 1024, 1, e, lds);
    }
    else if constexpr (K == PH_NORM2) phase_norm<true>(p, l, p.out);
    else if constexpr (K == PH_TOPK) phase_topk(p, lds);
    else if constexpr (K == PH_GATHER) phase_gather(p);
    else if constexpr (K == PH_MOE1) {
        EpiMoe1 e{(bf16_t*)(ws + WS_HID)};
        gemm_naive((const bf16_t*)(ws + WS_XG), 1024, (size_t)2048 * 1024, (const bf16_t*)(ws + WS_WGU) + (size_t)l * 16 * 4096 * 1024, 1024, (size_t)4096 * 1024, 2048, 4096, 1024, NE, e, lds);
    }
    else if constexpr (K == PH_MOE2) {
        EpiMoe2 e{(bf16_t*)(ws + WS_YE), (const float*)(ws + WS_GATE)};
        gemm_naive((const bf16_t*)(ws + WS_HID), 2048, (size_t)2048 * 2048, (const bf16_t*)(ws + WS_WD) + (size_t)l * 16 * 1024 * 2048, 2048, (size_t)1024 * 2048, 2048, 1024, 2048, NE, e, lds);
    }
    else if constexpr (K == PH_COMBINE) phase_combine(p, l);
    else if constexpr (K == PH_PRO) { pro_mod(p, lds); pro_weights(p, lds); }
}

#if ONE_LAUNCH
__global__ void __launch_bounds__(NTHREADS, 2) mega(Params p) {
    extern __shared__ __attribute__((aligned(16))) unsigned char lds_raw[];
    float* lds = (float*)lds_raw;
    cg::grid_group grid = cg::this_grid();
#define PHASE(K) do { run_phase<K>(p, l, lds); grid.sync(); } while (0)
    { const int l = 0; PHASE(PH_PRO); }
#pragma unroll 1
    for (int l = 0; l < DEPTH; ++l) {
        PHASE(PH_NORM1); PHASE(PH_INPROJ); PHASE(PH_QKPOST); PHASE(PH_ATTN); PHASE(PH_SSM); PHASE(PH_SSMPOST); PHASE(PH_GLU); PHASE(PH_UP1); PHASE(PH_UP2);
        PHASE(PH_OUT); PHASE(PH_NORM2); PHASE(PH_TOPK); PHASE(PH_GATHER); PHASE(PH_MOE1); PHASE(PH_MOE2);
        run_phase<PH_COMBINE>(p, l, lds); if (l + 1 < DEPTH) grid.sync();
    }
#undef PHASE
}
#else
template <int K> __global__ void __launch_bounds__(NTHREADS, 2) phase_kernel(Params p, int l) {
    extern __shared__ __attribute__((aligned(16))) unsigned char lds_raw[];
    run_phase<K>(p, l, (float*)lds_raw);
}
template <int K> static bool setup_phase() { return hipFuncSetAttribute((const void*)phase_kernel<K>, hipFuncAttributeMaxDynamicSharedMemorySize, LDS_BYTES) == hipSuccess; }
template <int K> static void launch_phase(const Params& p, int l, int grid, hipStream_t stream) { hipLaunchKernelGGL(phase_kernel<K>, dim3(grid), dim3(NTHREADS), LDS_BYTES, stream, p, l); }
template <int... Ks> static bool setup_all(std::integer_sequence<int, Ks...>) { bool ok = true; ((ok = setup_phase<Ks>() && ok), ...); return ok; }
template <int... Ks> static void launch_layer(const Params& p, int l, int grid, hipStream_t stream, std::integer_sequence<int, Ks...>) { (launch_phase<Ks>(p, l, grid, stream), ...); }
#endif

extern "C" void kernel_launch(void* const* d_in, const int* in_sizes, int n_in, void* d_out, int out_size, void* d_ws, size_t ws_size, hipStream_t stream) {
    static int grid = 0;
    if (grid == 0) {
        if (n_in != 26 || out_size != T * D || ws_size < WS_END) { fprintf(stderr, "kernel_launch: unexpected shapes: n_in %d out %d ws %zu (need %zu)\n", n_in, out_size, ws_size, (size_t)WS_END); grid = -1; return; }
        int dev = 0, cus = 0, per_cu = 0;
        (void)hipGetDevice(&dev); (void)hipDeviceGetAttribute(&cus, hipDeviceAttributeMultiprocessorCount, dev);
#if ONE_LAUNCH
        if (hipFuncSetAttribute((const void*)mega, hipFuncAttributeMaxDynamicSharedMemorySize, LDS_BYTES) != hipSuccess) { fprintf(stderr, "kernel_launch: hipFuncSetAttribute failed\n"); grid = -1; return; }
        (void)hipOccupancyMaxActiveBlocksPerMultiprocessor(&per_cu, (const void*)mega, NTHREADS, LDS_BYTES);
        if (per_cu < 1) { fprintf(stderr, "kernel_launch: occupancy query says %d blocks/CU\n", per_cu); grid = -1; return; }
#else
        if (!setup_all(std::make_integer_sequence<int, PH_PRO + 1>{})) { fprintf(stderr, "kernel_launch: hipFuncSetAttribute failed\n"); grid = -1; return; }
        (void)per_cu;
#endif
        grid = cus;
        (void)hipGetLastError();
    }
    if (grid < 0) return;
    Params p{};
    const float** pp = (const float**)&p;
    for (int i = 0; i < 26; ++i) pp[i] = (const float*)d_in[i];
    p.out = (float*)d_out; p.ws = (unsigned char*)d_ws;
#if ONE_LAUNCH
    void* args[] = {&p};
    hipError_t e = hipLaunchCooperativeKernel((const void*)mega, dim3(grid), dim3(NTHREADS), args, LDS_BYTES, stream);
    if (e != hipSuccess) fprintf(stderr, "cooperative launch failed: %s (grid %d)\n", hipGetErrorString(e), grid);
#else
    launch_phase<PH_PRO>(p, 0, grid, stream);
    for (int l = 0; l < DEPTH; ++l) launch_layer(p, l, grid, stream, std::make_integer_sequence<int, PH_PER_LAYER>{});
#endif
}
```

```cpp
#include <hip/hip_runtime.h>
#include <hip/hip_cooperative_groups.h>
#include <hip/hip_bf16.h>
#include <cstdio>
#include <cstdint>
#include <utility>
namespace cg = cooperative_groups;

#ifndef ONE_LAUNCH
#define ONE_LAUNCH 1
#endif
#ifndef FAST_MOE
#define FAST_MOE 1
#endif
#ifndef FAST_INPROJ
#define FAST_INPROJ 1
#endif
#ifndef MOE_FP8
#define MOE_FP8 1
#endif
#ifndef INPROJ_FP8
#define INPROJ_FP8 1
#endif
#ifndef MOE_GATHER
#define MOE_GATHER 1
#endif
#ifndef BG_CONVERT
#define BG_CONVERT 1
#endif
#ifndef CHAIN_REP
#define CHAIN_REP 0
#endif
#ifndef COMBINE_PROBE
#define COMBINE_PROBE 0
#ifndef ROUTER_ROWS
#define ROUTER_ROWS 4
#endif
#endif
#ifndef FAST_ATTN
#define FAST_ATTN 1
#endif
#ifndef FAST_SSM
#define FAST_SSM 1
#endif
#ifndef FAST_SMALLGEMM
#define FAST_SMALLGEMM 1
#endif
static_assert(FAST_SSM && FAST_INPROJ, "the naive S5 / in-projection paths are not maintained for this workspace map");

typedef unsigned short bf16_t;
typedef unsigned v4u __attribute__((ext_vector_type(4)));
typedef unsigned v2u __attribute__((ext_vector_type(2)));
typedef float f32x4 __attribute__((ext_vector_type(4)));

constexpr int D = 1024, NB = 4, S = 4096, T = NB * S, DEPTH = 2;
constexpr int HD = 64, NQH = 8, NKVH = 2, DATT = 512, DKV = 128;
constexpr int DSSM = 512, NG = 32, NP = 64;
constexpr int NE = 16, CAP = 512, DFF = 2048;
constexpr int NIN = 3328;
constexpr int CL = 32, CLS = 5, NCH = S / CL;
constexpr int CU = CL * 16;
constexpr int UXW = CU + 256;
constexpr int RG = NB * NCH;
static_assert((1 << CLS) == CL && CL % 16 == 0 && UXW % 128 == 0 && CU % 128 == 0 && RG % 256 == 0, "S5 chunk geometry");
constexpr float EPS = 1e-6f;
constexpr float QSCALE = 0.125f * 1.4426950408889634f;
constexpr int NTHREADS = 512, NWAVES = 8;
constexpr int LDS_BYTES = 147456;

constexpr size_t MiB = 1u << 20;
constexpr size_t WS_CTL = 0;
constexpr size_t WS_ZERO = 512 * 1024;
constexpr size_t WS_MOD = 1 * MiB;
constexpr size_t WS_WIN = 2 * MiB;
constexpr size_t WS_WGLU = 15 * MiB;
constexpr size_t WS_WSU = 16 * MiB;
constexpr size_t WS_WAU = 18 * MiB;
constexpr size_t WS_WOUT = 20 * MiB;
constexpr size_t WS_WGU = 24 * MiB;
constexpr size_t WS_H8 = 152 * MiB;
constexpr size_t WS_H8A = 168 * MiB;
constexpr size_t WS_WIN8 = 184 * MiB;
constexpr size_t WS_WD = 280 * MiB;
constexpr size_t WS_SSMM = 408 * MiB;
constexpr size_t WS_SSMS = 568 * MiB;
constexpr size_t WS_SSMA = 600 * MiB;
constexpr size_t WS_ROPE = 601 * MiB;
constexpr size_t WS_AL = 601 * MiB + 65536;
constexpr size_t WS_GT = 640 * MiB;
constexpr size_t WS_H = 604 * MiB;
constexpr size_t WS_AFF = 636 * MiB;
constexpr size_t WS_IDX = 637 * MiB;
constexpr size_t WS_GATE = 637 * MiB + 128 * 1024;
constexpr size_t WS_INV = 637 * MiB + 256 * 1024;
constexpr size_t WS_SRC = 639 * MiB;
constexpr size_t WS_STG = 640 * MiB;
constexpr size_t WS_UX = WS_STG + 236 * MiB;
constexpr size_t WS_QB = WS_STG + 20 * MiB;
constexpr size_t WS_KB = WS_STG + 36 * MiB;
constexpr size_t WS_VB = WS_STG + 40 * MiB;
constexpr size_t WS_GS = WS_STG + 44 * MiB;
constexpr size_t WS_GA = WS_STG + 76 * MiB;
constexpr size_t WS_AO = WS_STG + 108 * MiB;
constexpr size_t WS_SLOC = WS_STG + 196 * MiB;
constexpr size_t WS_Z = WS_STG + 132 * MiB;
constexpr size_t WS_SO = WS_STG + 148 * MiB;
constexpr size_t WS_MG = WS_STG + 164 * MiB;
constexpr size_t WS_PQK = WS_STG + 196 * MiB;
constexpr size_t WS_YP = WS_STG + 236 * MiB;
constexpr size_t WS_XG = WS_STG;
constexpr size_t WS_HID = WS_STG + 64 * MiB;
constexpr size_t WS_YE = WS_STG + 192 * MiB;
constexpr size_t WS_END = WS_STG + 300 * MiB;

struct Params {
    const float *x, *c, *w_mod, *b_mod, *ln1_w, *ln2_w, *w_in, *lam_re, *lam_im, *log_dt, *b_re, *b_im, *c_re, *c_im, *ssm_d,
        *w_glu, *b_glu, *q_norm_w, *k_norm_w, *w_ssm_up, *w_attn_up, *w_out, *w_router, *w_eg, *w_eu, *w_ed;
    float* out;
    unsigned char* ws;
};

__device__ __forceinline__ int opaque_tid() { int t = threadIdx.x; asm volatile("" : "+v"(t)); return t; }
__device__ __forceinline__ int opaque_bid() { int b = blockIdx.x; asm volatile("" : "+s"(b)); return b; }
__device__ __forceinline__ float bf2f(bf16_t v) { return __uint_as_float(((unsigned)v) << 16); }
__device__ __forceinline__ unsigned f2bf(float f) { unsigned u = __float_as_uint(f); return (u + 0x7fffu + ((u >> 16) & 1u)) >> 16; }
typedef float f32x2_t __attribute__((ext_vector_type(2))); typedef __bf16 bf16x2_t __attribute__((ext_vector_type(2)));
__device__ __forceinline__ unsigned pk2(float lo, float hi) { f32x2_t v = {lo, hi}; bf16x2_t b = __builtin_convertvector(v, bf16x2_t); return __builtin_bit_cast(unsigned, b); }
constexpr float FP8_WSCALE = 32.0f;
__device__ __forceinline__ float clamp448(float v) { return __builtin_fminf(__builtin_fmaxf(v, -448.0f), 448.0f); }
__device__ __forceinline__ unsigned pk4_fp8(float a, float b, float c, float d) {
    int w = 0;
    w = __builtin_amdgcn_cvt_pk_fp8_f32(clamp448(a), clamp448(b), w, false);
    w = __builtin_amdgcn_cvt_pk_fp8_f32(clamp448(c), clamp448(d), w, true);
    return (unsigned)w;
}
__device__ __forceinline__ float lo16(unsigned w) { return __uint_as_float(w << 16); }
__device__ __forceinline__ float hi16(unsigned w) { return __uint_as_float(w & 0xffff0000u); }
__device__ __forceinline__ float wave_sum(float v, int lane) {
#pragma unroll
    for (int o = 32; o > 0; o >>= 1) v += __int_as_float(__builtin_amdgcn_ds_bpermute((lane ^ o) << 2, __float_as_int(v)));
    return v;
}
__device__ __forceinline__ float sigmoidf_(float v) { return __builtin_amdgcn_rcpf(1.0f + __builtin_amdgcn_exp2f(-1.4426950408889634f * v)); }
__device__ __forceinline__ float siluf_(float v) { return v * __builtin_amdgcn_rcpf(1.0f + __builtin_amdgcn_exp2f(-1.4426950408889634f * v)); }
__device__ __forceinline__ float gelu_tanh(float y) { const float u = 0.7978845608028654f * (y + 0.044715f * y * y * y); return 0.5f * y * (1.0f + tanhf(u)); }

__device__ __forceinline__ void pro_mod(const Params& p, float* lds) {
    const int tid = opaque_tid(), w = tid >> 6, lane = tid & 63;
    float* mod = (float*)(p.ws + WS_MOD);
    for (int it = blockIdx.x; it < 192; it += gridDim.x) {
        const int l = it / 96, n0 = (it % 96) * 64;
        const float* W = p.w_mod + (size_t)l * 1024 * 6144;
        float a0 = 0.f, a1 = 0.f, a2 = 0.f, a3 = 0.f;
        for (int kk = 0; kk < 128; kk += 16) {
            float wv[16];
#pragma unroll
            for (int u = 0; u < 16; ++u) wv[u] = W[(size_t)(w * 128 + kk + u) * 6144 + n0 + lane];
#pragma unroll
            for (int u = 0; u < 16; ++u) {
                const int k = w * 128 + kk + u;
                a0 += siluf_(p.c[k]) * wv[u]; a1 += siluf_(p.c[1024 + k]) * wv[u]; a2 += siluf_(p.c[2048 + k]) * wv[u]; a3 += siluf_(p.c[3072 + k]) * wv[u];
            }
        }
        lds[(w * 4 + 0) * 64 + lane] = a0; lds[(w * 4 + 1) * 64 + lane] = a1; lds[(w * 4 + 2) * 64 + lane] = a2; lds[(w * 4 + 3) * 64 + lane] = a3;
        __syncthreads();
        if (tid < 256) {
            const int b = tid >> 6; float s = 0.f;
            for (int w2 = 0; w2 < 8; ++w2) s += lds[(w2 * 4 + b) * 64 + lane];
            mod[(size_t)(l * 4 + b) * 6144 + n0 + lane] = s + p.b_mod[l * 6144 + n0 + lane];
        }
        __syncthreads();
    }
}
__device__ __forceinline__ int inproj_row(int n) {
    if (n < 512 || n >= 1280) return n;
    if (n < 1152) {
        const int hh = (n - 512) >> 6, d = n & 63, q4 = d >> 4, bj = q4 & 1, o = (q4 >> 1) * 16 + (d & 15);
        const int tile = hh < 8 ? 2 + (hh >> 2) : 4, wc = hh < 8 ? (hh & 3) : hh - 8;
        return tile * 256 + bj * 128 + wc * 32 + o;
    }
    const int vc = n - 1152, wc = 2 + (vc >> 6), dv = vc & 63;
    return 1024 + (dv >> 5) * 128 + wc * 32 + (dv & 31);
}
struct TItem { const float* W; bf16_t* WT; int K, N, k0, n0, drow0, mode, fp8; };
__device__ __forceinline__ void titem_load(const TItem& t, int lane, f32x4 (&v)[8]) {
#pragma unroll
    for (int i = 0; i < 8; ++i) v[i] = __builtin_nontemporal_load((const f32x4*)(t.W + (size_t)(t.k0 + i * 8 + (lane >> 3)) * t.N + t.n0 + (lane & 7) * 4));
}
__device__ __forceinline__ void titem_store(const TItem& t, int lane, const f32x4 (&v)[8], float* scr) {
#pragma unroll
    for (int i = 0; i < 8; ++i) { float* d = scr + (i * 8 + (lane >> 3)) * 33 + (lane & 7) * 4; d[0] = v[i].x; d[1] = v[i].y; d[2] = v[i].z; d[3] = v[i].w; }
    asm volatile("s_waitcnt lgkmcnt(0)" ::: "memory");
    const int c = lane & 7;
#pragma unroll
    for (int j = 0; j < 4; ++j) {
        const int n = (lane >> 3) + 8 * j; const float* s = scr + (8 * c) * 33 + n;
        const int drow = t.mode == 3 ? inproj_row(t.n0 + n) + t.drow0 : t.drow0 + n;
        if (t.fp8) {
            v2u o8; o8.x = pk4_fp8(s[0 * 33] * FP8_WSCALE, s[1 * 33] * FP8_WSCALE, s[2 * 33] * FP8_WSCALE, s[3 * 33] * FP8_WSCALE); o8.y = pk4_fp8(s[4 * 33] * FP8_WSCALE, s[5 * 33] * FP8_WSCALE, s[6 * 33] * FP8_WSCALE, s[7 * 33] * FP8_WSCALE);
            *(v2u*)((unsigned char*)t.WT + (size_t)drow * t.K + t.k0 + 8 * c) = o8;
        } else {
            v4u o; o.x = pk2(s[0 * 33], s[1 * 33]); o.y = pk2(s[2 * 33], s[3 * 33]); o.z = pk2(s[4 * 33], s[5 * 33]); o.w = pk2(s[6 * 33], s[7 * 33]);
            *(v4u*)(t.WT + (size_t)drow * t.K + t.k0 + 8 * c) = o;
        }
    }
    asm volatile("s_waitcnt lgkmcnt(0)" ::: "memory");
}
__device__ __forceinline__ void pro_rope(const Params& p) {
    float* rope = (float*)(p.ws + WS_ROPE);
    const int i = blockIdx.x * NTHREADS + opaque_tid();
    if (i < 1024) {
        const int pos = i >> 4, f = i & 15;
        const float inv = exp2f(-(float)f * (13.287712379549449f / 16.0f));
        float sn, cs; sincosf((float)pos * inv, &sn, &cs);
        rope[2 * i] = cs; rope[2 * i + 1] = sn;
    }
}
constexpr int EXP_ITEMS = 16 * 3072;
constexpr int BG_N1 = 3, BG_N2 = 10, BG_N3 = 10, BG_N4 = 6, BG_N5 = 10;
constexpr int BG_B1 = 0, BG_B2 = BG_B1 + 64 * 8 * BG_N1, BG_B3 = BG_B2 + 128 * 8 * BG_N2, BG_B4 = BG_B3 + 128 * 8 * BG_N3, BG_B5 = BG_B4 + 192 * 8 * BG_N4, BG_END = BG_B5 + 192 * 8 * BG_N5;
static_assert(BG_END <= EXP_ITEMS, "background conversion slots exceed the expert item count");
__device__ __forceinline__ TItem expert_item(const Params& p, int l, int idx) {
    const int e = idx / 3072, q = idx % 3072, which = q / 1024, r = q % 1024;
    const size_t le = (size_t)l * 16 + e;
    TItem t; t.mode = 0; t.fp8 = MOE_FP8;
    constexpr size_t ESZ = MOE_FP8 ? 1 : 2;
    if (which == 0) { t.W = p.w_eg + le * 1024 * 2048; t.K = 1024; t.N = 2048; t.WT = (bf16_t*)(p.ws + WS_WGU + le * 4096 * 1024 * ESZ); t.mode = 1; }
    else if (which == 1) { t.W = p.w_eu + le * 1024 * 2048; t.K = 1024; t.N = 2048; t.WT = (bf16_t*)(p.ws + WS_WGU + le * 4096 * 1024 * ESZ); t.mode = 2; }
    else { t.W = p.w_ed + le * 2048 * 1024; t.K = 2048; t.N = 1024; t.WT = (bf16_t*)(p.ws + WS_WD + le * 1024 * 2048 * ESZ); }
    const int nblk = t.N / 32, kb = r / nblk, nb = r % nblk; t.k0 = 64 * kb; t.n0 = 32 * nb;
    t.drow0 = t.n0;
    if (t.mode) t.drow0 = (t.n0 / 128) * 256 + (t.n0 % 128) + (t.mode == 2 ? 128 : 0);
    return t;
}
__device__ __forceinline__ void bg_convert(const Params& p, int l, float* lds, int base, int n, int rank, int nb) {
    const int tid = opaque_tid(), w = tid >> 6, lane = tid & 63;
    float* scr = lds + w * (64 * 33 + 16);
    const int first = base + rank * 8 + w, step = nb * 8;
    TItem ta = expert_item(p, l, first); f32x4 va[8]; titem_load(ta, lane, va);
    for (int k = 0; k < n; k += 2) {
        TItem tb = ta; f32x4 vb[8];
        if (k + 1 < n) { tb = expert_item(p, l, first + (k + 1) * step); titem_load(tb, lane, vb); }
        titem_store(ta, lane, va, scr);
        if (k + 1 < n) {
            if (k + 2 < n) { ta = expert_item(p, l, first + (k + 2) * step); titem_load(ta, lane, va); }
            titem_store(tb, lane, vb, scr);
        }
    }
}
__device__ __forceinline__ TItem pro_item(const Params& p, int it, int PER_L, int exp_base) {
    const int l = it / PER_L; int r = it % PER_L;
    if (r >= 2816) return expert_item(p, l, exp_base + r - 2816);
    TItem t; t.mode = 0; t.fp8 = 0;
    if (r < 1664) {
        t.W = p.w_in + (size_t)l * 1024 * NIN; t.K = 1024; t.N = NIN; t.WT = (bf16_t*)(p.ws + WS_WIN) + (size_t)l * NIN * 1024; t.mode = FAST_INPROJ ? 3 : 0;
        if (INPROJ_FP8 && (r % 104) * 32 >= 512) {
            t.k0 = 64 * (r / 104); t.n0 = 32 * (r % 104); t.drow0 = -512; t.fp8 = 1; t.WT = (bf16_t*)(p.ws + WS_WIN8 + (size_t)l * 2816 * 1024); return t;
        }
        if (FAST_INPROJ) { t.k0 = 64 * (r / 104); t.n0 = 32 * (r % 104); t.drow0 = 0; return t; }
    }
    else if (r < 1792) { r -= 1664; t.W = p.w_glu + (size_t)l * 512 * 512; t.K = 512; t.N = 512; t.WT = (bf16_t*)(p.ws + WS_WGLU) + (size_t)l * 512 * 512; }
    else if (r < 2048) { r -= 1792; t.W = p.w_ssm_up + (size_t)l * 512 * 1024; t.K = 512; t.N = 1024; t.WT = (bf16_t*)(p.ws + WS_WSU) + (size_t)l * 1024 * 512; }
    else if (r < 2304) { r -= 2048; t.W = p.w_attn_up + (size_t)l * 512 * 1024; t.K = 512; t.N = 1024; t.WT = (bf16_t*)(p.ws + WS_WAU) + (size_t)l * 1024 * 512; }
    else { r -= 2304; t.W = p.w_out + (size_t)l * 1024 * 1024; t.K = 1024; t.N = 1024; t.WT = (bf16_t*)(p.ws + WS_WOUT) + (size_t)l * 1024 * 1024; }
    const int nblk = t.N / 32, kb = r / nblk, nb = r % nblk; t.k0 = 64 * kb; t.n0 = 32 * nb; t.drow0 = t.n0;
    return t;
}
__device__ __forceinline__ void pro_weights(const Params& p, float* lds) {
    const int tid = opaque_tid(), w = tid >> 6, lane = tid & 63;
    float* scr = lds + w * (64 * 33 + 16);
    const int gw = blockIdx.x * NWAVES + w, NGW = gridDim.x * NWAVES;
    constexpr int EXPB = (BG_CONVERT && ONE_LAUNCH) ? BG_END : 0, PER_L = 2816 + EXP_ITEMS - EXPB, TOTAL = 2 * PER_L;
    if (gw >= TOTAL) return;
    TItem ta = pro_item(p, gw, PER_L, EXPB); f32x4 va[8]; titem_load(ta, lane, va);
    for (int it = gw; it < TOTAL; it += 2 * NGW) {
        TItem tb = ta; f32x4 vb[8]; const bool hb = it + NGW < TOTAL;
        if (hb) { tb = pro_item(p, it + NGW, PER_L, EXPB); titem_load(tb, lane, vb); }
        titem_store(ta, lane, va, scr);
        if (hb) {
            if (it + 2 * NGW < TOTAL) { ta = pro_item(p, it + 2 * NGW, PER_L, EXPB); titem_load(ta, lane, va); }
            titem_store(tb, lane, vb, scr);
        }
    }
}

template <bool ROUTER>
__device__ __forceinline__ void phase_norm_rows(const Params& p, int l, const float* xin, float* lds, int gw, int NGW, int mend) {
    const int tid = opaque_tid(), lane = tid & 63;
    const float* lnw = (ROUTER ? p.ln2_w : p.ln1_w) + l * 1024;
    const float* mod = (const float*)(p.ws + WS_MOD);
    bf16_t* H = (bf16_t*)(p.ws + WS_H);
    float* AFF = (float*)(p.ws + WS_AFF);
    if (ROUTER) {
        const float* wr = p.w_router + (size_t)l * 1024 * 16;
        __syncthreads();
        for (int i = tid; i < 4096; i += NTHREADS) { const f32x4 v = *(const f32x4*)(wr + (size_t)i * 4); const int k = i >> 2, e4 = (i & 3) * 4; lds[(e4 + 0) * 1024 + k] = v.x; lds[(e4 + 1) * 1024 + k] = v.y; lds[(e4 + 2) * 1024 + k] = v.z; lds[(e4 + 3) * 1024 + k] = v.w; }
        __syncthreads();
    }
    f32x4 vn[4];
    if (gw < mend) {
#pragma unroll
        for (int j = 0; j < 4; ++j) vn[j] = *(const f32x4*)(xin + (size_t)gw * 1024 + j * 256 + lane * 4);
    }
    for (int m = gw; m < mend; m += NGW) {
        const int b = m >> 12;
        const float* modb = mod + (size_t)(l * 4 + b) * 6144 + (ROUTER ? 3072 : 0);
        f32x4 v[4]; float ss = 0.f;
#pragma unroll
        for (int j = 0; j < 4; ++j) { v[j] = vn[j]; ss += v[j].x * v[j].x + v[j].y * v[j].y + v[j].z * v[j].z + v[j].w * v[j].w; }
        if (m + NGW < mend) {
#pragma unroll
            for (int j = 0; j < 4; ++j) vn[j] = *(const f32x4*)(xin + (size_t)(m + NGW) * 1024 + j * 256 + lane * 4);
        }
        const float r = rsqrtf(wave_sum(ss, lane) * (1.0f / 1024.0f) + EPS);
        float lg[16];
        if (ROUTER) {
#pragma unroll
            for (int e = 0; e < 16; ++e) lg[e] = 0.f;
        }
#pragma unroll
        for (int j = 0; j < 4; ++j) {
            const int col = j * 256 + lane * 4;
            const f32x4 w4 = *(const f32x4*)(lnw + col), sh = *(const f32x4*)(modb + col), sc = *(const f32x4*)(modb + 1024 + col);
            f32x4 h;
            h.x = v[j].x * r * w4.x * (1.f + sc.x) + sh.x; h.y = v[j].y * r * w4.y * (1.f + sc.y) + sh.y;
            h.z = v[j].z * r * w4.z * (1.f + sc.z) + sh.z; h.w = v[j].w * r * w4.w * (1.f + sc.w) + sh.w;
            if (ROUTER && MOE_FP8) *(unsigned*)((unsigned char*)(p.ws + WS_H8) + (size_t)m * 1024 + col) = pk4_fp8(h.x, h.y, h.z, h.w);
            else {
                v2u o; o.x = pk2(h.x, h.y); o.y = pk2(h.z, h.w); *(v2u*)(H + (size_t)m * 1024 + col) = o;
                if (INPROJ_FP8 && !ROUTER) *(unsigned*)((unsigned char*)(p.ws + WS_H8A) + (size_t)m * 1024 + col) = pk4_fp8(h.x, h.y, h.z, h.w);
            }
            if (ROUTER) {
#pragma unroll
                for (int e = 0; e < 16; ++e) { const f32x4 ww = *(const f32x4*)(lds + e * 1024 + col); lg[e] += h.x * ww.x + h.y * ww.y + h.z * ww.z + h.w * ww.w; }
            }
        }
        if (ROUTER) {
#define XCH(x, msk) __int_as_float(__builtin_amdgcn_ds_bpermute((lane ^ (msk)) << 2, __float_as_int(x)))
            float r8[8], r4[4], r2[2], r1;
            { const bool hi = lane & 32;
#pragma unroll
              for (int i = 0; i < 8; ++i) { const float keep = hi ? lg[8 + i] : lg[i], send = hi ? lg[i] : lg[8 + i]; r8[i] = keep + XCH(send, 32); } }
            { const bool hi = lane & 16;
#pragma unroll
              for (int i = 0; i < 4; ++i) { const float keep = hi ? r8[4 + i] : r8[i], send = hi ? r8[i] : r8[4 + i]; r4[i] = keep + XCH(send, 16); } }
            { const bool hi = lane & 8;
#pragma unroll
              for (int i = 0; i < 2; ++i) { const float keep = hi ? r4[2 + i] : r4[i], send = hi ? r4[i] : r4[2 + i]; r2[i] = keep + XCH(send, 8); } }
            { const bool hi = lane & 4; const float keep = hi ? r2[1] : r2[0], send = hi ? r2[0] : r2[1]; r1 = keep + XCH(send, 4); }
            r1 += XCH(r1, 2); r1 += XCH(r1, 1);
            float mx = r1;
            mx = fmaxf(mx, XCH(mx, 4)); mx = fmaxf(mx, XCH(mx, 8)); mx = fmaxf(mx, XCH(mx, 16)); mx = fmaxf(mx, XCH(mx, 32));
            const float ex = expf(r1 - mx);
            float sum = ex;
            sum += XCH(sum, 4); sum += XCH(sum, 8); sum += XCH(sum, 16); sum += XCH(sum, 32);
#undef XCH
            if ((lane & 3) == 0) AFF[(size_t)(b * 16 + (lane >> 2)) * 4096 + (m & 4095)] = ex / sum;
        }
    }
}
template <int NR>
__device__ __forceinline__ void phase_norm2_rowsN(const Params& p, int l, const float* xin, float* lds, int gw, int NGW, int mend) {
    const int tid = opaque_tid(), lane = tid & 63;
    const float* lnw = p.ln2_w + l * 1024;
    const float* mod = (const float*)(p.ws + WS_MOD);
    float* AFF = (float*)(p.ws + WS_AFF);
    {
        const float* wr = p.w_router + (size_t)l * 1024 * 16;
        __syncthreads();
        for (int i = tid; i < 4096; i += NTHREADS) { const f32x4 v = *(const f32x4*)(wr + (size_t)i * 4); const int k = i >> 2, e4 = (i & 3) * 4; lds[(e4 + 0) * 1024 + k] = v.x; lds[(e4 + 1) * 1024 + k] = v.y; lds[(e4 + 2) * 1024 + k] = v.z; lds[(e4 + 3) * 1024 + k] = v.w; }
        __syncthreads();
    }
    for (int m = gw; m < mend; m += NR * NGW) {
        const int b = m >> 12;
        const float* modb = mod + (size_t)(l * 4 + b) * 6144 + 3072;
        float rs[NR];
        {
#pragma unroll
            for (int q = 0; q < NR; ++q) {
                f32x4 v[4]; float ss = 0.f;
#pragma unroll
                for (int j = 0; j < 4; ++j) v[j] = *(const f32x4*)(xin + (size_t)(m + q * NGW) * 1024 + j * 256 + lane * 4);
#pragma unroll
                for (int j = 0; j < 4; ++j) ss += v[j].x * v[j].x + v[j].y * v[j].y + v[j].z * v[j].z + v[j].w * v[j].w;
                rs[q] = ss;
            }
#pragma unroll
            for (int q = 0; q < NR; ++q) rs[q] = rsqrtf(wave_sum(rs[q], lane) * (1.0f / 1024.0f) + EPS);
        }
        float lg[NR][16];
#pragma unroll
        for (int q = 0; q < NR; ++q)
#pragma unroll
            for (int e = 0; e < 16; ++e) lg[q][e] = 0.f;
#pragma unroll 1
        for (int j = 0; j < 4; ++j) {
            const int col = j * 256 + lane * 4;
            const f32x4 w4 = *(const f32x4*)(lnw + col), sh = *(const f32x4*)(modb + col), sc = *(const f32x4*)(modb + 1024 + col);
            f32x4 h[NR];
#pragma unroll
            for (int q = 0; q < NR; ++q) {
                const f32x4 x = *(const f32x4*)(xin + (size_t)(m + q * NGW) * 1024 + col); const float r = rs[q];
                h[q].x = x.x * r * w4.x * (1.f + sc.x) + sh.x; h[q].y = x.y * r * w4.y * (1.f + sc.y) + sh.y; h[q].z = x.z * r * w4.z * (1.f + sc.z) + sh.z; h[q].w = x.w * r * w4.w * (1.f + sc.w) + sh.w;
                *(unsigned*)((unsigned char*)(p.ws + WS_H8) + (size_t)(m + q * NGW) * 1024 + col) = pk4_fp8(h[q].x, h[q].y, h[q].z, h[q].w);
            }
#pragma unroll
            for (int e = 0; e < 16; ++e) {
                const f32x4 ww = *(const f32x4*)(lds + e * 1024 + col);
#pragma unroll
                for (int q = 0; q < NR; ++q) lg[q][e] += h[q].x * ww.x + h[q].y * ww.y + h[q].z * ww.z + h[q].w * ww.w;
            }
        }
#define XCH(x, msk) __int_as_float(__builtin_amdgcn_ds_bpermute((lane ^ (msk)) << 2, __float_as_int(x)))
#pragma unroll
        for (int q = 0; q < NR; ++q) {
            float r8[8], r4[4], r2[2], r1;
            { const bool hi = lane & 32;
#pragma unroll
              for (int i = 0; i < 8; ++i) { const float keep = hi ? lg[q][8 + i] : lg[q][i], send = hi ? lg[q][i] : lg[q][8 + i]; r8[i] = keep + XCH(send, 32); } }
            { const bool hi = lane & 16;
#pragma unroll
              for (int i = 0; i < 4; ++i) { const float keep = hi ? r8[4 + i] : r8[i], send = hi ? r8[i] : r8[4 + i]; r4[i] = keep + XCH(send, 16); } }
            { const bool hi = lane & 8;
#pragma unroll
              for (int i = 0; i < 2; ++i) { const float keep = hi ? r4[2 + i] : r4[i], send = hi ? r4[i] : r4[2 + i]; r2[i] = keep + XCH(send, 8); } }
            { const bool hi = lane & 4; const float keep = hi ? r2[1] : r2[0], send = hi ? r2[0] : r2[1]; r1 = keep + XCH(send, 4); }
            r1 += XCH(r1, 2); r1 += XCH(r1, 1);
            float mx = r1;
            mx = fmaxf(mx, XCH(mx, 4)); mx = fmaxf(mx, XCH(mx, 8)); mx = fmaxf(mx, XCH(mx, 16)); mx = fmaxf(mx, XCH(mx, 32));
            const float ex = expf(r1 - mx);
            float sum = ex;
            sum += XCH(sum, 4); sum += XCH(sum, 8); sum += XCH(sum, 16); sum += XCH(sum, 32);
            if ((lane & 3) == 0) AFF[(size_t)(b * 16 + (lane >> 2)) * 4096 + ((m + q * NGW) & 4095)] = ex / sum;
        }
#undef XCH
    }
}
template <bool ROUTER>
__device__ __forceinline__ void phase_norm(const Params& p, int l, const float* xin, float* lds) {
    const int w = opaque_tid() >> 6;
    phase_norm_rows<ROUTER>(p, l, xin, lds, blockIdx.x * NWAVES + w, gridDim.x * NWAVES, T);
}

template <class Epi>
__device__ __forceinline__ void gemm_naive(const bf16_t* A, int lda, size_t strideA, const bf16_t* Bt, int ldb, size_t strideB, int M, int N, int K, int ngroups, const Epi& epi, float* lds) {
    const int tid = opaque_tid(), ty = tid >> 4, tx = tid & 15;
    float* As = lds;
    float* Bs = lds + 16 * 132;
    const int ntm = M / 128, ntn = N / 256, per_g = ntm * ntn, total = ngroups * per_g;
    for (int tile = blockIdx.x; tile < total; tile += gridDim.x) {
        const int g = tile / per_g, r = tile % per_g, m0 = (r / ntn) * 128, n0 = (r % ntn) * 256;
        const bf16_t* Ag = A + (size_t)g * strideA; const bf16_t* Bg = Bt + (size_t)g * strideB;
        float acc[4][16];
#pragma unroll
        for (int i = 0; i < 4; ++i)
#pragma unroll
            for (int j = 0; j < 16; ++j) acc[i][j] = 0.f;
        for (int k0 = 0; k0 < K; k0 += 16) {
            __syncthreads();
            {
                const int row = tid >> 2, k4 = (tid & 3) * 4;
                const v2u a = *(const v2u*)(Ag + (size_t)(m0 + row) * lda + k0 + k4);
                As[(k4 + 0) * 132 + row] = lo16(a.x); As[(k4 + 1) * 132 + row] = hi16(a.x); As[(k4 + 2) * 132 + row] = lo16(a.y); As[(k4 + 3) * 132 + row] = hi16(a.y);
                const int brow = tid >> 1, k8 = (tid & 1) * 8;
                const v4u b = *(const v4u*)(Bg + (size_t)(n0 + brow) * ldb + k0 + k8);
                Bs[(k8 + 0) * 260 + brow] = lo16(b.x); Bs[(k8 + 1) * 260 + brow] = hi16(b.x); Bs[(k8 + 2) * 260 + brow] = lo16(b.y); Bs[(k8 + 3) * 260 + brow] = hi16(b.y);
                Bs[(k8 + 4) * 260 + brow] = lo16(b.z); Bs[(k8 + 5) * 260 + brow] = hi16(b.z); Bs[(k8 + 6) * 260 + brow] = lo16(b.w); Bs[(k8 + 7) * 260 + brow] = hi16(b.w);
            }
            __syncthreads();
#pragma unroll 2
            for (int k = 0; k < 16; ++k) {
                const f32x4 a = *(const f32x4*)(As + k * 132 + ty * 4);
                const f32x4 b0 = *(const f32x4*)(Bs + k * 260 + tx * 8), b1 = *(const f32x4*)(Bs + k * 260 + tx * 8 + 4);
                const f32x4 b2 = *(const f32x4*)(Bs + k * 260 + 128 + tx * 8), b3 = *(const f32x4*)(Bs + k * 260 + 128 + tx * 8 + 4);
                const float av[4] = {a.x, a.y, a.z, a.w};
                const float bv[16] = {b0.x, b0.y, b0.z, b0.w, b1.x, b1.y, b1.z, b1.w, b2.x, b2.y, b2.z, b2.w, b3.x, b3.y, b3.z, b3.w};
#pragma unroll
                for (int i = 0; i < 4; ++i)
#pragma unroll
                    for (int j = 0; j < 16; ++j) acc[i][j] += av[i] * bv[j];
            }
        }
#pragma unroll
        for (int i = 0; i < 4; ++i)
#pragma unroll
            for (int j = 0; j < 8; ++j) epi(g, m0 + ty * 4 + i, n0, tx * 8 + j, acc[i][j], acc[i][8 + j]);
    }
}


namespace pg8 {
#define PG8_LAS __attribute__((address_space(3)))
typedef short bf16x8 __attribute__((ext_vector_type(8)));
typedef unsigned u32x4 __attribute__((ext_vector_type(4)));
constexpr int BM = 256, BK = 64, HALF = 128, HTB = HALF * BK * 2  , STAGE_BYTES = 8 * HTB, NXCD = 8, WGM = 8;
__host__ __device__ __forceinline__ int lds_byte(int r, int c) { const int st = (r >> 4) * 2 + (c >> 5), rr = r & 15, cc = c & 31, ob = rr * 64 + cc * 2; return st * 1024 + (ob ^ (((ob >> 9) & 1) << 5)); }
__host__ __device__ __forceinline__ void stage_rc(int b, int& R, int& C) { const int st = b / 1024, sb = b % 1024, swz = sb ^ (((sb >> 9) & 1) << 5); R = (st >> 1) * 16 + swz / 64; C = (st & 1) * 32 + (swz % 64) / 2; }
__host__ __device__ __forceinline__ int perm32(int rho) { const int n = rho >> 4, i = rho & 15; return 8 * (i >> 2) + 4 * n + (i & 3); }
typedef int v4i_t __attribute__((ext_vector_type(4))); typedef int v8i_t __attribute__((ext_vector_type(8)));
__device__ __forceinline__ v8i_t cat8(bf16x8 lo, bf16x8 hi) { const v4i_t a = __builtin_bit_cast(v4i_t, lo), b = __builtin_bit_cast(v4i_t, hi); return __builtin_shufflevector(a, b, 0, 1, 2, 3, 4, 5, 6, 7); }
__device__ __forceinline__ void mfma_fp8_acc(f32x4& acc, v8i_t a, v8i_t b, int scale) {
    asm volatile("s_nop 1\n\tv_mfma_scale_f32_16x16x128_f8f6f4 %0, %1, %2, %0, %3, %3 op_sel_hi:[0,0,0]" : "+v"(acc) : "v"(a), "v"(b), "v"(scale));
}
struct Unit { int pm, pn; };
struct Gemm { const bf16_t* A; const bf16_t* Bt; int M, N, K, lda, ldb, mt_per_group; size_t strideB; const bf16_t* A2; const bf16_t* Bt2; const int* rowsrc; };
struct StaticOrder {
    int nM, nN, nwg, G, c;
    __host__ __device__ void init(int M, int N, int G_, int c_) { nM = M / BM; nN = N / BM; nwg = nM * nN; G = G_; c = c_; }
    __host__ __device__ bool next(int i, Unit& u) const { return at((long)i * G + c, u); }
    __host__ __device__ bool at(long L, Unit& u) const {
        if (L < 0 || L >= nwg) return false;
        int wgid = (int)L; { const int q = nwg / NXCD, r = nwg % NXCD, xcd = wgid % NXCD, off = wgid / NXCD; wgid = (xcd < r ? xcd * (q + 1) : r * (q + 1) + (xcd - r) * q) + off; }
        const int nig = WGM * nN, gid = wgid / nig, fm = gid * WGM, gsz = (nM - fm) < WGM ? (nM - fm) : WGM;
        u.pm = fm + ((wgid % nig) % gsz); u.pn = (wgid % nig) / gsz; return true;
    }
    __device__ __forceinline__ void a_ready(const Unit&) const {}
    __device__ __forceinline__ void done(const Unit&) const {}
};
template <class Epi, class Sched, bool ALIGN_EPI = false, bool SP2 = false, bool CHAIN2 = false, bool GATHER = false, bool FP8 = false>
__device__ __forceinline__ void gemm_phase(PG8_LAS unsigned char* lds, const Gemm g, const Sched& S, const Epi& E) {
    const int tid = opaque_tid(), wid = __builtin_amdgcn_readfirstlane(tid >> 6), lane = tid & 63, wr = wid >> 2, wc = wid & 3, fr = lane & 15, fq = lane >> 4;
    const int K = g.K, nt = K / BK;
    int fp8_unit_scale = 0x7f7f7f7f; asm volatile("" : "+v"(fp8_unit_scale));
    unsigned voffA[2], voffB[2];
    unsigned cG0[2], cG1[2], sG0[2], sG1[2]; int gR[2], gC[2];
#pragma unroll
    for (int i = 0; i < 2; ++i) { int R, C; stage_rc(tid * 16 + i * 8192, R, C); const int Rb = Epi::PERM ? ((R & ~31) + perm32(R & 31)) : R;
        voffA[i] = (unsigned)(R * g.lda + C) * 2u; voffB[i] = (unsigned)(Rb * g.ldb + C) * 2u; gR[i] = R; gC[i] = C; }
    const size_t kstep = (size_t)(BK * 2);
    const size_t hstepA = GATHER ? 0 : (size_t)HALF * g.lda * 2, hstepB = (size_t)HALF * g.ldb * 2;
    const size_t tstepA = 2 * hstepA, tstepB = 2 * hstepB;
    const size_t gstepB = g.strideB * 2;
    const unsigned ldsw = (unsigned)wid * 1024u;
    const int aoff = lds_byte(wr * 64 + fr, fq * 8), boff = lds_byte(wc * 32 + fr, fq * 8);
#define PG8_VC0 (GATHER ? cG0 : voffA)
#define PG8_VC1 (GATHER ? cG1 : voffA)
#define PG8_VS0 (GATHER ? sG0 : voffA)
#define PG8_VS1 (GATHER ? sG1 : voffA)
#define PG8_GOFF(dst0, dst1, pm_) do { _Pragma("unroll") for (int _i = 0; _i < 2; ++_i) { \
        dst0[_i] = (unsigned)(g.rowsrc[(pm_) * BM + gR[_i]] * g.lda + gC[_i]) * 2u; dst1[_i] = (unsigned)(g.rowsrc[(pm_) * BM + HALF + gR[_i]] * g.lda + gC[_i]) * 2u; } } while (0)
#define PG8_SA(b, h) (((b) * 2 + (h)) * HTB)
#define PG8_SB(b, h) ((4 + (b) * 2 + (h)) * HTB)
#define PG8_STAGE(bufoff, gbase, voff) do { _Pragma("unroll") for (int _i = 0; _i < 2; ++_i) \
        __builtin_amdgcn_global_load_lds((const unsigned*)((const char*)(gbase) + (voff)[_i]), (PG8_LAS unsigned*)(lds + (bufoff) + ldsw + _i * 8192), 16, 0, 0); } while (0)
#define PG8_LDA(dst, b, h) do { _Pragma("unroll") for (int m = 0; m < 4; ++m) _Pragma("unroll") for (int k = 0; k < 2; ++k) dst[m][k] = *(const PG8_LAS bf16x8*)(lds + PG8_SA(b, h) + aoff + m * 2048 + k * 1024); } while (0)
#define PG8_LDB(dst, b, h) do { _Pragma("unroll") for (int n = 0; n < 2; ++n) _Pragma("unroll") for (int k = 0; k < 2; ++k) dst[n][k] = *(const PG8_LAS bf16x8*)(lds + PG8_SB(b, h) + boff + n * 2048 + k * 1024); } while (0)
#define PG8_MMA(ai, bj, At, Bt) do { __builtin_amdgcn_s_setprio(1); _Pragma("unroll") for (int m = 0; m < 4; ++m) _Pragma("unroll") for (int n = 0; n < 2; ++n) { \
        if constexpr (FP8) mfma_fp8_acc(acc[ai][bj][m][n], cat8(Bt[n][0], Bt[n][1]), cat8(At[m][0], At[m][1]), fp8_unit_scale); \
        else { _Pragma("unroll") for (int k = 0; k < 2; ++k) acc[ai][bj][m][n] = __builtin_amdgcn_mfma_f32_16x16x32_bf16(Bt[n][k], At[m][k], acc[ai][bj][m][n], 0, 0, 0); } } \
        __builtin_amdgcn_s_setprio(0); } while (0)
#define PG8_WAIT_V(n) asm volatile("s_waitcnt vmcnt(" #n ")" ::: "memory")
#define PG8_WAIT_L(n) asm volatile("s_waitcnt lgkmcnt(" #n ")" ::: "memory")
#define PG8_BAR __builtin_amdgcn_s_barrier()
#define PG8_SCHED __builtin_amdgcn_sched_barrier(0)
    Unit cur, nxt; int ui = 0;
    if (!S.next(0, cur)) return;
    f32x4 acc[2][2][4][2];
#pragma unroll
    for (int a = 0; a < 2; ++a)
#pragma unroll
        for (int b = 0; b < 2; ++b)
#pragma unroll
            for (int m = 0; m < 4; ++m)
#pragma unroll
                for (int n = 0; n < 2; ++n) acc[a][b][m][n] = (f32x4){0.f, 0.f, 0.f, 0.f};
    bf16x8 At[4][2], B0[2][2], B1[2][2];
    const char* cA = (const char*)g.A + (size_t)cur.pm * tstepA; const char* cB = (const char*)g.Bt + (size_t)(cur.pm / g.mt_per_group) * gstepB + (size_t)cur.pn * tstepB;
    if constexpr (GATHER) { PG8_GOFF(cG0, cG1, cur.pm); }
    S.a_ready(cur);
    if constexpr (SP2) {
        PG8_STAGE(PG8_SB(0, 0), cB, voffB); PG8_STAGE(PG8_SB(0, 1), cB + hstepB, voffB); PG8_STAGE(PG8_SA(0, 0), cA, PG8_VC0); PG8_STAGE(PG8_SA(0, 1), cA + hstepA, PG8_VC1);
        if (wr == 1) PG8_BAR;
        PG8_WAIT_V(2); PG8_BAR;
        PG8_STAGE(PG8_SB(1, 0), cB + kstep, voffB); PG8_STAGE(PG8_SA(1, 0), cA + kstep, PG8_VC0); PG8_STAGE(PG8_SB(1, 1), cB + hstepB + kstep, voffB);
        PG8_WAIT_V(6); PG8_BAR;
    } else {
        PG8_STAGE(PG8_SB(0, 0), cB, voffB); PG8_STAGE(PG8_SA(0, 0), cA, voffA); PG8_STAGE(PG8_SB(0, 1), cB + hstepB, voffB); PG8_STAGE(PG8_SA(0, 1), cA + hstepA, voffA);
        if (wr == 1) PG8_BAR;
        PG8_WAIT_V(4); PG8_BAR;
        PG8_STAGE(PG8_SB(1, 0), cB + kstep, voffB); PG8_STAGE(PG8_SA(1, 0), cA + kstep, voffA); PG8_STAGE(PG8_SB(1, 1), cB + hstepB + kstep, voffB);
        PG8_WAIT_V(6); PG8_BAR;
    }
    for (;;) {
        const bool has_next = S.next(ui + 1, nxt);
        unsigned nG0[2], nG1[2];
        if constexpr (GATHER) { if (has_next) { PG8_GOFF(nG0, nG1, nxt.pm); } else { nG0[0] = cG0[0]; nG0[1] = cG0[1]; nG1[0] = cG1[0]; nG1[1] = cG1[1]; } }
        const bf16_t* nbA = (CHAIN2 && !(ui & 1)) ? g.A2 : g.A; const bf16_t* nbB = (CHAIN2 && !(ui & 1)) ? g.Bt2 : g.Bt;
        const char* nA = has_next ? (const char*)nbA + (size_t)nxt.pm * tstepA : cA; const char* nB = has_next ? (const char*)nbB + (size_t)(nxt.pm / g.mt_per_group) * gstepB + (size_t)nxt.pn * tstepB : cB;
        for (int t = 0; t < nt; t += 2) {
            const bool last = (t == nt - 2);
            const char* a1 = cA + (size_t)(t + 1) * kstep;
            const char* a2 = last ? nA : cA + (size_t)(t + 2) * kstep; const char* b2 = last ? nB : cB + (size_t)(t + 2) * kstep;
            const char* a3 = a2 + kstep; const char* b3 = b2 + kstep;
            if (last && has_next) S.a_ready(nxt);
            if constexpr (GATHER) { if (last) { sG0[0] = nG0[0]; sG0[1] = nG0[1]; sG1[0] = nG1[0]; sG1[1] = nG1[1]; } else { sG0[0] = cG0[0]; sG0[1] = cG0[1]; sG1[0] = cG1[0]; sG1[1] = cG1[1]; } }
            if constexpr (SP2) {
            PG8_LDB(B0, 0, 0); PG8_LDB(B1, 0, 1); PG8_SCHED; PG8_LDA(At, 0, 0); PG8_STAGE(PG8_SA(1, 1), a1 + hstepA, PG8_VC1);
            PG8_WAIT_V(8); PG8_WAIT_L(0); PG8_BAR; PG8_MMA(0, 0, At, B0); PG8_MMA(0, 1, At, B1); PG8_BAR; PG8_SCHED;
            PG8_LDA(At, 0, 1); PG8_STAGE(PG8_SB(0, 0), b2, voffB); PG8_STAGE(PG8_SB(0, 1), b2 + hstepB, voffB); PG8_STAGE(PG8_SA(0, 0), a2, PG8_VS0);
            PG8_WAIT_V(8); PG8_WAIT_L(0); PG8_BAR; PG8_MMA(1, 0, At, B0); PG8_MMA(1, 1, At, B1); PG8_BAR; PG8_SCHED;
            PG8_LDB(B0, 1, 0); PG8_LDB(B1, 1, 1); PG8_SCHED; PG8_LDA(At, 1, 0); PG8_STAGE(PG8_SA(0, 1), a2 + hstepA, PG8_VS1);
            PG8_WAIT_V(8); PG8_WAIT_L(0); PG8_BAR; PG8_MMA(0, 0, At, B0); PG8_MMA(0, 1, At, B1); PG8_BAR; PG8_SCHED;
            PG8_LDA(At, 1, 1); PG8_STAGE(PG8_SB(1, 0), b3, voffB); PG8_STAGE(PG8_SB(1, 1), b3 + hstepB, voffB); PG8_STAGE(PG8_SA(1, 0), a3, PG8_VS0);
            PG8_WAIT_V(8); PG8_WAIT_L(0); PG8_BAR; PG8_MMA(1, 0, At, B0); PG8_MMA(1, 1, At, B1); PG8_BAR; PG8_SCHED;
            } else {
            PG8_LDB(B0, 0, 0); PG8_SCHED; PG8_LDA(At, 0, 0); PG8_STAGE(PG8_SA(1, 1), a1 + hstepA, voffA);
            PG8_WAIT_L(8); PG8_BAR; PG8_WAIT_L(0); PG8_MMA(0, 0, At, B0); PG8_BAR; PG8_SCHED;
            PG8_LDB(B1, 0, 1); PG8_STAGE(PG8_SB(0, 0), b2, voffB);
            PG8_BAR; PG8_WAIT_L(0); PG8_MMA(0, 1, At, B1); PG8_BAR;
            PG8_LDA(At, 0, 1); PG8_STAGE(PG8_SA(0, 0), a2, voffA);
            PG8_BAR; PG8_WAIT_L(0); PG8_MMA(1, 0, At, B0); PG8_BAR; PG8_SCHED;
            PG8_STAGE(PG8_SB(0, 1), b2 + hstepB, voffB);
            PG8_WAIT_V(6); PG8_BAR; PG8_MMA(1, 1, At, B1); PG8_BAR;
            PG8_LDB(B0, 1, 0); PG8_SCHED; PG8_LDA(At, 1, 0); PG8_STAGE(PG8_SA(0, 1), a2 + hstepA, voffA);
            PG8_WAIT_L(8); PG8_BAR; PG8_WAIT_L(0); PG8_MMA(0, 0, At, B0); PG8_BAR; PG8_SCHED;
            PG8_LDB(B1, 1, 1); PG8_STAGE(PG8_SB(1, 0), b3, voffB);
            PG8_BAR; PG8_WAIT_L(0); PG8_MMA(0, 1, At, B1); PG8_BAR;
            PG8_LDA(At, 1, 1); PG8_STAGE(PG8_SA(1, 0), a3, voffA);
            PG8_BAR; PG8_WAIT_L(0); PG8_MMA(1, 0, At, B0); PG8_BAR; PG8_SCHED;
            PG8_STAGE(PG8_SB(1, 1), b3 + hstepB, voffB);
            PG8_WAIT_V(6); PG8_BAR; PG8_MMA(1, 1, At, B1); PG8_BAR;
            }
        }
        if constexpr (ALIGN_EPI) { if (wr == 0) PG8_BAR; }
        if constexpr (FP8) asm volatile("s_nop 15\n\ts_nop 15" ::: "memory");
        bool midpoint = false;
        if constexpr (CHAIN2) { if (!(ui & 1)) { midpoint = true; E.mid(acc, cur, wr, wc, fr, fq); } }
        if constexpr (!Epi::AFTER_DRAIN) { if (!midpoint) { E(acc, cur, wr, wc, fr, fq); S.done(cur); } }
        if (!has_next) break;
        if (!midpoint) {
#pragma unroll
        for (int a = 0; a < 2; ++a)
#pragma unroll
            for (int b = 0; b < 2; ++b)
#pragma unroll
                for (int m = 0; m < 4; ++m)
#pragma unroll
                    for (int n = 0; n < 2; ++n) acc[a][b][m][n] = (f32x4){0.f, 0.f, 0.f, 0.f};
        }
        cur = nxt; cA = nA; cB = nB; ++ui;
        if constexpr (GATHER) { cG0[0] = sG0[0]; cG0[1] = sG0[1]; cG1[0] = sG1[0]; cG1[1] = sG1[1]; }
        if constexpr (ALIGN_EPI) { if (wr == 1) PG8_BAR; }
    }
    PG8_WAIT_V(0);
    if constexpr (!ALIGN_EPI) { if (wr == 0) PG8_BAR; }
    PG8_BAR;
    if constexpr (Epi::AFTER_DRAIN) { E.fused(acc, cur, wr, wc, fr, fq, lds, wid, lane); S.done(cur); }
#undef PG8_SA
#undef PG8_VC0
#undef PG8_VC1
#undef PG8_VS0
#undef PG8_VS1
#undef PG8_GOFF
#undef PG8_SB
#undef PG8_STAGE
#undef PG8_LDA
#undef PG8_LDB
#undef PG8_MMA
#undef PG8_WAIT_V
#undef PG8_WAIT_L
#undef PG8_BAR
#undef PG8_SCHED
}
}

struct EpiInProj {
    bf16_t *UX, *VB, *GS, *GA; float* PQK;
    __device__ __forceinline__ void one(int m, int n, float v) const {
        if (n < 512) { const int b = m >> 12, t = m & 4095, g = n >> 4; UX[((size_t)g * RG + b * NCH + (t >> CLS)) * UXW + (t & (CL - 1)) * 16 + (n & 15)] = (bf16_t)f2bf(v); }
        else if (n < 1152) PQK[(size_t)m * 640 + (n - 512)] = v;
        else if (n < 1280) VB[(size_t)m * 128 + (n - 1152)] = (bf16_t)f2bf(v);
        else if (n < 2304) GS[(size_t)m * 1024 + (n - 1280)] = (bf16_t)f2bf(sigmoidf_(v));
        else GA[(size_t)m * 1024 + (n - 2304)] = (bf16_t)f2bf(sigmoidf_(v));
    }
    __device__ __forceinline__ void operator()(int, int m, int n0, int j, float v0, float v1) const { one(m, n0 + j, v0); one(m, n0 + 128 + j, v1); }
};
struct EpiGlu {
    const bf16_t* Z; bf16_t* SO; const float* bias;
    __device__ __forceinline__ void one(int m, int n, float v) const { const float z = bf2f(Z[(size_t)m * 512 + n]); SO[(size_t)m * 512 + n] = (bf16_t)f2bf(z * sigmoidf_(v + bias[n])); }
    __device__ __forceinline__ void operator()(int, int m, int n0, int j, float v0, float v1) const { one(m, n0 + j, v0); one(m, n0 + 128 + j, v1); }
};
template <bool ADD> struct EpiUp {
    const bf16_t* G; bf16_t* MG;
    __device__ __forceinline__ void one(int m, int n, float v) const {
        const size_t i = (size_t)m * 1024 + n; float r = bf2f(G[i]) * v; if (ADD) r += bf2f(MG[i]); MG[i] = (bf16_t)f2bf(r);
    }
    __device__ __forceinline__ void operator()(int, int m, int n0, int j, float v0, float v1) const { one(m, n0 + j, v0); one(m, n0 + 128 + j, v1); }
};
struct EpiOut {
    const float* xin; float* XR; const float* mod_l;
    __device__ __forceinline__ void one(int m, int n, float v) const { const int b = m >> 12; const size_t i = (size_t)m * 1024 + n; XR[i] = xin[i] + mod_l[(size_t)b * 6144 + 2048 + n] * v; }
    __device__ __forceinline__ void operator()(int, int m, int n0, int j, float v0, float v1) const { one(m, n0 + j, v0); one(m, n0 + 128 + j, v1); }
};
struct EpiMoe1 {
    bf16_t* HID;
    __device__ __forceinline__ void operator()(int g, int m, int n0, int j, float v0, float v1) const { HID[((size_t)g * 2048 + m) * 2048 + (n0 >> 1) + j] = (bf16_t)f2bf(siluf_(v0) * v1); }
};
struct EpiMoe2 {
    bf16_t* YE; const float* GATE;
    __device__ __forceinline__ void one(int g, int m, int n, float v) const { const int b = m >> 9, c = m & 511; YE[((size_t)g * 2048 + m) * 1024 + n] = (bf16_t)f2bf(v * GATE[(size_t)(b * 16 + g) * 512 + c]); }
    __device__ __forceinline__ void operator()(int g, int m, int n0, int j, float v0, float v1) const { one(g, m, n0 + j, v0); one(g, m, n0 + 128 + j, v1); }
};

#define ACC_ARG const f32x4 (&acc)[2][2][4][2]
__device__ __forceinline__ v4u pack8(const f32x4 a, const f32x4 b) { v4u w; w.x = pk2(a.x, a.y); w.y = pk2(a.z, a.w); w.z = pk2(b.x, b.y); w.w = pk2(b.z, b.w); return w; }
__device__ __forceinline__ void unpack8(const v4u w, f32x4& a, f32x4& b) { a.x = lo16(w.x); a.y = hi16(w.x); a.z = lo16(w.y); a.w = hi16(w.y); b.x = lo16(w.z); b.y = hi16(w.z); b.z = lo16(w.w); b.w = hi16(w.w); }
__device__ __forceinline__ f32x4 exp2_4(const f32x4 t) { f32x4 e; e.x = __builtin_amdgcn_exp2f(t.x); e.y = __builtin_amdgcn_exp2f(t.y); e.z = __builtin_amdgcn_exp2f(t.z); e.w = __builtin_amdgcn_exp2f(t.w); return e; }
__device__ __forceinline__ f32x4 rcp4(const f32x4 d) { f32x4 r; r.x = __builtin_amdgcn_rcpf(d.x); r.y = __builtin_amdgcn_rcpf(d.y); r.z = __builtin_amdgcn_rcpf(d.z); r.w = __builtin_amdgcn_rcpf(d.w); return r; }
__device__ __forceinline__ f32x4 sig4s(const f32x4 v, const float scale) { return rcp4(exp2_4(v * (-1.4426950408889634f * scale)) + 1.0f); }
__device__ __forceinline__ f32x4 sig4(const f32x4 v) { return sig4s(v, 1.0f); }
__device__ __forceinline__ f32x4 silu4(const f32x4 v) { return v * sig4(v); }
template <int LOG2S> __device__ __forceinline__ f32x4 silu_mul_scaled(const f32x4 g, const f32x4 u) {
    constexpr float s = (float)(1 << LOG2S), s2 = s * s;
    return (g * u) * rcp4(exp2_4(g * (-1.4426950408889634f / s) + (float)(2 * LOG2S)) + s2);
}

struct XEpiOut {
    static constexpr bool PERM = false, AFTER_DRAIN = false;
    const float* xin; float* XR; const float* mod_l;
    __device__ __forceinline__ void operator()(ACC_ARG, const pg8::Unit& u, int wr, int wc, int fr, int fq) const {
#pragma unroll
        for (int ai = 0; ai < 2; ++ai)
#pragma unroll
            for (int m = 0; m < 4; ++m) {
                const int row = u.pm * 256 + ai * 128 + wr * 64 + m * 16 + fr, b = row >> 12;
#pragma unroll
                for (int bj = 0; bj < 2; ++bj)
#pragma unroll
                    for (int n = 0; n < 2; ++n) {
                        const int col = u.pn * 256 + bj * 128 + wc * 32 + n * 16 + 4 * fq; const size_t i = (size_t)row * 1024 + col;
                        const f32x4 xv = *(const f32x4*)(xin + i), gv = *(const f32x4*)(mod_l + (size_t)b * 6144 + 2048 + col);
                        *(f32x4*)(XR + i) = xv + gv * acc[ai][bj][m][n];
                    }
            }
    }
};
struct XEpiGlu {
    static constexpr bool PERM = true, AFTER_DRAIN = false;
    const bf16_t* Z; bf16_t* SO; const float* bias;
    __device__ __forceinline__ void operator()(ACC_ARG, const pg8::Unit& u, int wr, int wc, int fr, int fq) const {
#pragma unroll
        for (int ai = 0; ai < 2; ++ai)
#pragma unroll
            for (int m = 0; m < 4; ++m) {
                const int row = u.pm * 256 + ai * 128 + wr * 64 + m * 16 + fr;
#pragma unroll
                for (int bj = 0; bj < 2; ++bj) {
                    const int col = u.pn * 256 + bj * 128 + wc * 32 + 8 * fq; const size_t i = (size_t)row * 512 + col;
                    f32x4 z0, z1; unpack8(*(const v4u*)(Z + i), z0, z1);
                    const f32x4 b0 = *(const f32x4*)(bias + col), b1 = *(const f32x4*)(bias + col + 4);
                    *(v4u*)(SO + i) = pack8(z0 * sig4(acc[ai][bj][m][0] + b0), z1 * sig4(acc[ai][bj][m][1] + b1));
                }
            }
    }
};
template <bool ADD> struct XEpiUp {
    static constexpr bool PERM = true, AFTER_DRAIN = false;
    const bf16_t* G; bf16_t* MG;
    __device__ __forceinline__ void operator()(ACC_ARG, const pg8::Unit& u, int wr, int wc, int fr, int fq) const {
#pragma unroll
        for (int ai = 0; ai < 2; ++ai)
#pragma unroll
            for (int m = 0; m < 4; ++m) {
                const int row = u.pm * 256 + ai * 128 + wr * 64 + m * 16 + fr;
#pragma unroll
                for (int bj = 0; bj < 2; ++bj) {
                    const int col = u.pn * 256 + bj * 128 + wc * 32 + 8 * fq; const size_t i = (size_t)row * 1024 + col;
                    f32x4 g0, g1; unpack8(*(const v4u*)(G + i), g0, g1);
                    f32x4 r0 = g0 * acc[ai][bj][m][0], r1 = g1 * acc[ai][bj][m][1];
                    if (ADD) { f32x4 p0, p1; unpack8(*(const v4u*)(MG + i), p0, p1); r0 += p0; r1 += p1; }
                    *(v4u*)(MG + i) = pack8(r0, r1);
                }
            }
    }
};
struct XEpiMoe1 {
    static constexpr bool PERM = true, AFTER_DRAIN = false;
    bf16_t* HID;
    __device__ __forceinline__ void operator()(ACC_ARG, const pg8::Unit& u, int wr, int wc, int fr, int fq) const {
#pragma unroll
        for (int ai = 0; ai < 2; ++ai)
#pragma unroll
            for (int m = 0; m < 4; ++m) {
                const int row = u.pm * 256 + ai * 128 + wr * 64 + m * 16 + fr;
                const int col = u.pn * 128 + wc * 32 + 8 * fq;
                *(v4u*)(HID + (size_t)row * 2048 + col) = pack8(silu4(acc[ai][0][m][0]) * acc[ai][1][m][0], silu4(acc[ai][0][m][1]) * acc[ai][1][m][1]);
            }
    }
};
struct XEpiMoe1F8 {
    static constexpr bool PERM = true, AFTER_DRAIN = false;
    unsigned char* HID;
    __device__ __forceinline__ void operator()(ACC_ARG, const pg8::Unit& u, int wr, int wc, int fr, int fq) const {
        asm volatile("" : "+v"(fr), "+v"(fq));
        constexpr float is = 1.0f / FP8_WSCALE;
#pragma unroll
        for (int ai = 0; ai < 2; ++ai)
#pragma unroll
            for (int m = 0; m < 4; ++m) {
                const int row = u.pm * 256 + ai * 128 + wr * 64 + m * 16 + fr;
                const int col = u.pn * 128 + wc * 32 + 8 * fq;
                const f32x4 h0 = silu_mul_scaled<5>(acc[ai][0][m][0], acc[ai][1][m][0]), h1 = silu_mul_scaled<5>(acc[ai][0][m][1], acc[ai][1][m][1]);
                v2u o; o.x = pk4_fp8(h0.x, h0.y, h0.z, h0.w); o.y = pk4_fp8(h1.x, h1.y, h1.z, h1.w);
                *(v2u*)(HID + (size_t)row * 2048 + col) = o;
            }
    }
};
struct XEpiGatesF8 {
    static constexpr bool PERM = true, AFTER_DRAIN = false;
    bf16_t *GS, *GA;
    __device__ __forceinline__ void operator()(ACC_ARG, const pg8::Unit& u, int wr, int wc, int fr, int fq) const {
        asm volatile("" : "+v"(fr), "+v"(fq));
        constexpr float is = 1.0f / FP8_WSCALE;
        bf16_t* G = u.pn < 4 ? GS : GA; const int cbase = (u.pn & 3) * 256 + wc * 32 + 8 * fq;
#pragma unroll
        for (int ai = 0; ai < 2; ++ai)
#pragma unroll
            for (int m = 0; m < 4; ++m) {
                const int row = u.pm * 256 + ai * 128 + wr * 64 + m * 16 + fr;
#pragma unroll
                for (int bj = 0; bj < 2; ++bj) *(v4u*)(G + (size_t)row * 1024 + cbase + bj * 128) = pack8(sig4(acc[ai][bj][m][0] * is), sig4(acc[ai][bj][m][1] * is));
            }
    }
};
struct XEpiMoe2 {
    static constexpr bool PERM = true, AFTER_DRAIN = false;
    bf16_t* YE; const float* GATE; float oscale;
    __device__ __forceinline__ void operator()(ACC_ARG, const pg8::Unit& u, int wr, int wc, int fr, int fq) const {
        asm volatile("" : "+v"(fr), "+v"(fq));
#pragma unroll
        for (int ai = 0; ai < 2; ++ai)
#pragma unroll
            for (int m = 0; m < 4; ++m) {
                const int row = u.pm * 256 + ai * 128 + wr * 64 + m * 16 + fr, e = row >> 11, r = row & 2047, b = r >> 9, c = r & 511;
                const float gt = GATE[(size_t)(b * 16 + e) * 512 + c] * oscale;
#pragma unroll
                for (int bj = 0; bj < 2; ++bj) {
                    const int col = u.pn * 256 + bj * 128 + wc * 32 + 8 * fq;
                    *(v4u*)(YE + (size_t)row * 1024 + col) = pack8(acc[ai][bj][m][0] * gt, acc[ai][bj][m][1] * gt);
                }
            }
    }
};
struct XEpiInProj {
    static constexpr bool PERM = true, AFTER_DRAIN = false;
    bf16_t *UX, *QB, *KB, *VB, *GS, *GA; const float *rope, *qnw, *knw; int pn_off; float asc;
    __device__ __forceinline__ void operator()(ACC_ARG, const pg8::Unit& u, int wr, int wc, int fr, int fq) const {
        { const int t_ = opaque_tid(); fr = t_ & 15; fq = (t_ >> 4) & 3; }
        const int pn = u.pn + pn_off, row0 = u.pm * 256 + wr * 64 + fr;
        if (pn < 2) {
#pragma unroll
            for (int ai = 0; ai < 2; ++ai)
#pragma unroll
                for (int m = 0; m < 4; ++m) {
                    const int row = row0 + ai * 128 + m * 16, b = row >> 12, t = row & 4095;
#pragma unroll
                    for (int bj = 0; bj < 2; ++bj) {
                        const int c0 = pn * 256 + bj * 128 + wc * 32 + 8 * fq, g = c0 >> 4, ci0 = c0 & 15;
                        *(v4u*)(UX + ((size_t)g * RG + b * NCH + (t >> CLS)) * UXW + (t & (CL - 1)) * 16 + ci0) = pack8(acc[ai][bj][m][0] * asc, acc[ai][bj][m][1] * asc);
                    }
                }
        } else if (pn >= 5) {
            bf16_t* G = pn < 9 ? GS : GA; const int cbase = (pn < 9 ? pn - 5 : pn - 9) * 256 + wc * 32 + 8 * fq;
#pragma unroll
            for (int ai = 0; ai < 2; ++ai)
#pragma unroll
                for (int m = 0; m < 4; ++m) {
                    const int row = row0 + ai * 128 + m * 16;
#pragma unroll
                    for (int bj = 0; bj < 2; ++bj) *(v4u*)(G + (size_t)row * 1024 + cbase + bj * 128) = pack8(sig4s(acc[ai][bj][m][0], asc), sig4s(acc[ai][bj][m][1], asc));
                }
        } else if (pn == 4 && wc >= 2) {
#pragma unroll
            for (int ai = 0; ai < 2; ++ai)
#pragma unroll
                for (int m = 0; m < 4; ++m) {
                    const int row = row0 + ai * 128 + m * 16;
#pragma unroll
                    for (int bj = 0; bj < 2; ++bj) *(v4u*)(VB + (size_t)row * 128 + (wc - 2) * 64 + bj * 32 + 8 * fq) = pack8(acc[ai][bj][m][0] * asc, acc[ai][bj][m][1] * asc);
                }
        } else {
            const bool isq = pn < 4; const int h = isq ? (pn - 2) * 4 + wc : wc;
            const float* nw = isq ? qnw : knw; const float osc = isq ? QSCALE : 1.0f;
            const int d1 = (fq & 2) * 16 + (fq & 1) * 8, i0 = (fq & 1) * 8, lane = fq * 16 + fr;
            const f32x4 w1a = *(const f32x4*)(nw + d1), w1b = *(const f32x4*)(nw + d1 + 4), w2a = *(const f32x4*)(nw + d1 + 16), w2b = *(const f32x4*)(nw + d1 + 20);
            bf16_t* dst = (isq ? QB : KB) + h * 64 + d1; const int pitch = isq ? 512 : 128;
#pragma unroll
            for (int ai = 0; ai < 2; ++ai)
#pragma unroll
                for (int m = 0; m < 4; ++m) {
                    const int row = row0 + ai * 128 + m * 16, t = row & 4095, pos = (fq & 2) ? (t & 63) : (t >> 6);
                    const f32x4 x1a = acc[ai][0][m][0] * asc, x1b = acc[ai][0][m][1] * asc, x2a = acc[ai][1][m][0] * asc, x2b = acc[ai][1][m][1] * asc;
                    float ss = x1a.x * x1a.x + x1a.y * x1a.y + x1a.z * x1a.z + x1a.w * x1a.w + x1b.x * x1b.x + x1b.y * x1b.y + x1b.z * x1b.z + x1b.w * x1b.w
                             + x2a.x * x2a.x + x2a.y * x2a.y + x2a.z * x2a.z + x2a.w * x2a.w + x2b.x * x2b.x + x2b.y * x2b.y + x2b.z * x2b.z + x2b.w * x2b.w;
                    ss += __int_as_float(__builtin_amdgcn_ds_bpermute((lane ^ 16) << 2, __float_as_int(ss)));
                    ss += __int_as_float(__builtin_amdgcn_ds_bpermute((lane ^ 32) << 2, __float_as_int(ss)));
                    const float r = rsqrtf(ss * (1.0f / 64.0f) + EPS);
                    const f32x4* rp = (const f32x4*)(rope + (size_t)(pos * 16 + i0) * 2);
                    const f32x4 cs0 = rp[0], cs1 = rp[1], cs2 = rp[2], cs3 = rp[3];
                    const f32x4 n1a = x1a * r * w1a, n1b = x1b * r * w1b, n2a = x2a * r * w2a, n2b = x2b * r * w2b;
                    f32x4 o1a, o1b, o2a, o2b;
                    o1a.x = n1a.x * cs0.x - n2a.x * cs0.y; o2a.x = n1a.x * cs0.y + n2a.x * cs0.x;
                    o1a.y = n1a.y * cs0.z - n2a.y * cs0.w; o2a.y = n1a.y * cs0.w + n2a.y * cs0.z;
                    o1a.z = n1a.z * cs1.x - n2a.z * cs1.y; o2a.z = n1a.z * cs1.y + n2a.z * cs1.x;
                    o1a.w = n1a.w * cs1.z - n2a.w * cs1.w; o2a.w = n1a.w * cs1.w + n2a.w * cs1.z;
                    o1b.x = n1b.x * cs2.x - n2b.x * cs2.y; o2b.x = n1b.x * cs2.y + n2b.x * cs2.x;
                    o1b.y = n1b.y * cs2.z - n2b.y * cs2.w; o2b.y = n1b.y * cs2.w + n2b.y * cs2.z;
                    o1b.z = n1b.z * cs3.x - n2b.z * cs3.y; o2b.z = n1b.z * cs3.y + n2b.z * cs3.x;
                    o1b.w = n1b.w * cs3.z - n2b.w * cs3.w; o2b.w = n1b.w * cs3.w + n2b.w * cs3.z;
                    bf16_t* dp = dst + (size_t)row * pitch;
                    *(v4u*)dp = pack8(o1a * osc, o1b * osc); *(v4u*)(dp + 16) = pack8(o2a * osc, o2b * osc);
                }
        }
    }
};
struct XEpiSloc {
    static constexpr bool PERM = false, AFTER_DRAIN = false;
    float* SLOC;
    __device__ __forceinline__ void operator()(ACC_ARG, const pg8::Unit& u, int wr, int wc, int fr, int fq) const {
#pragma unroll
        for (int ai = 0; ai < 2; ++ai)
#pragma unroll
            for (int m = 0; m < 4; ++m) {
                const int row = u.pm * 256 + ai * 128 + wr * 64 + m * 16 + fr;
#pragma unroll
                for (int bj = 0; bj < 2; ++bj)
#pragma unroll
                    for (int n = 0; n < 2; ++n) *(f32x4*)(SLOC + (size_t)row * 256 + u.pn * 256 + bj * 128 + wc * 32 + n * 16 + 4 * fq) = acc[ai][bj][m][n];
            }
    }
};
__device__ __forceinline__ float gelu_fast(float y) { return y * __builtin_amdgcn_rcpf(1.0f + __builtin_amdgcn_exp2f(-2.3022082f * (y + 0.044715f * y * y * y))); }
__device__ __forceinline__ f32x4 gelu4(const f32x4 v) { return v * rcp4(exp2_4(v * (v * v * (-2.3022082f * 0.044715f) + -2.3022082f)) + 1.0f); }
struct XEpiZ {
    static constexpr bool PERM = true, AFTER_DRAIN = false;
    bf16_t* Z;
    __device__ __forceinline__ void operator()(ACC_ARG, const pg8::Unit& u, int wr, int wc, int fr, int fq) const {
#pragma unroll
        for (int ai = 0; ai < 2; ++ai)
#pragma unroll
            for (int m = 0; m < 4; ++m) {
                const int row = u.pm * 256 + ai * 128 + wr * 64 + m * 16 + fr, g = row / RG, b = (row / NCH) % NB, ch = row % NCH;
#pragma unroll
                for (int bj = 0; bj < 2; ++bj) {
                    const int c0 = u.pn * 256 + bj * 128 + wc * 32 + 8 * fq, t = c0 >> 4, co0 = c0 & 15;
                    *(v4u*)(Z + ((size_t)b * 4096 + ch * CL + t) * 512 + g * 16 + co0) = pack8(gelu4(acc[ai][bj][m][0]), gelu4(acc[ai][bj][m][1]));
                }
            }
    }
};
struct InProjF8Order {
    pg8::StaticOrder so; int c;
    __device__ __forceinline__ bool next(int i, pg8::Unit& u) const {
        long L = -1;
        if (i < 2) L = c + 256 * i;
        else if (c >= 128 && c < 192) { if (i == 2) L = 512 + c; else if (i == 3) L = 384 + c; }
        else if (c >= 192) { if (i == 2) L = 384 + c; }
        return so.at(L, u);
    }
    __device__ __forceinline__ void a_ready(const pg8::Unit&) const {}
    __device__ __forceinline__ void done(const pg8::Unit&) const {}
};
struct OneUnitOrder {
    int n;
    __device__ __forceinline__ bool next(int i, pg8::Unit& u) const { if (i > 0 || (int)blockIdx.x >= n) return false; u.pm = blockIdx.x; u.pn = 0; return true; }
    __device__ __forceinline__ void a_ready(const pg8::Unit&) const {}
    __device__ __forceinline__ void done(const pg8::Unit&) const {}
};
struct XEpiUpChain {
    static constexpr bool PERM = true, AFTER_DRAIN = false;
    const bf16_t *GS, *GA; bf16_t* MG;
    __device__ __forceinline__ void mid(f32x4 (&acc)[2][2][4][2], const pg8::Unit& u, int wr, int wc, int fr, int fq) const {
        asm volatile("" : "+v"(fr), "+v"(fq));
#pragma unroll
        for (int ai = 0; ai < 2; ++ai)
#pragma unroll
            for (int m = 0; m < 4; ++m) {
                const int row = u.pm * 256 + ai * 128 + wr * 64 + m * 16 + fr;
#pragma unroll
                for (int bj = 0; bj < 2; ++bj) {
                    const int col = u.pn * 256 + bj * 128 + wc * 32 + 8 * fq; const size_t i = (size_t)row * 1024 + col;
                    f32x4 s0, s1, a0, a1; unpack8(*(const v4u*)(GS + i), s0, s1); unpack8(*(const v4u*)(GA + i), a0, a1);
                    f32x4 q0, q1;
                    q0.x = s0.x * __builtin_amdgcn_rcpf(fmaxf(a0.x, 1e-20f)); q0.y = s0.y * __builtin_amdgcn_rcpf(fmaxf(a0.y, 1e-20f)); q0.z = s0.z * __builtin_amdgcn_rcpf(fmaxf(a0.z, 1e-20f)); q0.w = s0.w * __builtin_amdgcn_rcpf(fmaxf(a0.w, 1e-20f));
                    q1.x = s1.x * __builtin_amdgcn_rcpf(fmaxf(a1.x, 1e-20f)); q1.y = s1.y * __builtin_amdgcn_rcpf(fmaxf(a1.y, 1e-20f)); q1.z = s1.z * __builtin_amdgcn_rcpf(fmaxf(a1.z, 1e-20f)); q1.w = s1.w * __builtin_amdgcn_rcpf(fmaxf(a1.w, 1e-20f));
                    acc[ai][bj][m][0] *= q0; acc[ai][bj][m][1] *= q1;
                }
                asm volatile("" ::: "memory");
            }
    }
    __device__ __forceinline__ void operator()(ACC_ARG, const pg8::Unit& u, int wr, int wc, int fr, int fq) const {
        asm volatile("" : "+v"(fr), "+v"(fq));
#pragma unroll
        for (int ai = 0; ai < 2; ++ai)
#pragma unroll
            for (int m = 0; m < 4; ++m) {
                const int row = u.pm * 256 + ai * 128 + wr * 64 + m * 16 + fr;
#pragma unroll
                for (int bj = 0; bj < 2; ++bj) {
                    const int col = u.pn * 256 + bj * 128 + wc * 32 + 8 * fq; const size_t i = (size_t)row * 1024 + col;
                    f32x4 a0, a1; unpack8(*(const v4u*)(GA + i), a0, a1);
                    a0.x = fmaxf(a0.x, 1e-20f); a0.y = fmaxf(a0.y, 1e-20f); a0.z = fmaxf(a0.z, 1e-20f); a0.w = fmaxf(a0.w, 1e-20f);
                    a1.x = fmaxf(a1.x, 1e-20f); a1.y = fmaxf(a1.y, 1e-20f); a1.z = fmaxf(a1.z, 1e-20f); a1.w = fmaxf(a1.w, 1e-20f);
                    *(v4u*)(MG + i) = pack8(acc[ai][bj][m][0] * a0, acc[ai][bj][m][1] * a1);
                }
            }
    }
};
struct FixedUnit2 {
    int pm, pn;
    __device__ __forceinline__ bool next(int i, pg8::Unit& u) const { if (i > 1) return false; u.pm = pm; u.pn = pn; return true; }
    __device__ __forceinline__ void a_ready(const pg8::Unit&) const {}
    __device__ __forceinline__ void done(const pg8::Unit&) const {}
};
template <class Epi, bool ALIGN>
__device__ __forceinline__ void run_gemm(float* lds, const bf16_t* A, int lda, const bf16_t* Bt, int ldb, int M, int N, int K, int mt_per_group, size_t strideB, const Epi& e) {
    pg8::Gemm g{A, Bt, M, N, K, lda, ldb, mt_per_group, strideB, nullptr, nullptr, nullptr};
    pg8::StaticOrder S; S.init(M, N, (int)gridDim.x, opaque_bid());
    pg8::gemm_phase<Epi, pg8::StaticOrder, ALIGN, true>((PG8_LAS unsigned char*)lds, g, S, e);
}

__device__ __forceinline__ void phase_qkpost(const Params& p, int l) {
    const float* PQK = (const float*)(p.ws + WS_PQK);
    bf16_t* QB = (bf16_t*)(p.ws + WS_QB); bf16_t* KB = (bf16_t*)(p.ws + WS_KB);
    const int total = T * 10;
    for (int i = blockIdx.x * NTHREADS + opaque_tid(); i < total; i += gridDim.x * NTHREADS) {
        const int m = i / 10, j = i % 10, t = m & 4095;
        const float* src = PQK + (size_t)m * 640 + j * 64;
        const float* nw = (j < 8 ? p.q_norm_w : p.k_norm_w) + l * 64;
        float xv[64]; float ss = 0.f;
#pragma unroll
        for (int d = 0; d < 64; ++d) { xv[d] = src[d]; ss += xv[d] * xv[d]; }
        const float r = rsqrtf(ss * (1.0f / 64.0f) + EPS);
#pragma unroll
        for (int d = 0; d < 64; ++d) xv[d] = xv[d] * r * nw[d];
        const float posr = (float)(t >> 6), posc = (float)(t & 63);
        const float osc = (j < 8) ? QSCALE : 1.0f;
        bf16_t* dst = (j < 8) ? (QB + (size_t)m * 512 + j * 64) : (KB + (size_t)m * 128 + (j - 8) * 64);
#pragma unroll
        for (int d = 0; d < 16; ++d) {
            const float inv = exp2f(-(float)d * (13.287712379549449f / 16.0f));
            float sr, cr, sc, cc; sincosf(posr * inv, &sr, &cr); sincosf(posc * inv, &sc, &cc);
            const float a1 = xv[d], a2 = xv[16 + d], b1 = xv[32 + d], b2 = xv[48 + d];
            dst[d] = (bf16_t)f2bf((a1 * cr - a2 * sr) * osc); dst[16 + d] = (bf16_t)f2bf((a1 * sr + a2 * cr) * osc);
            dst[32 + d] = (bf16_t)f2bf((b1 * cc - b2 * sc) * osc); dst[48 + d] = (bf16_t)f2bf((b1 * sc + b2 * cc) * osc);
        }
    }
}

namespace attn_body {
using bf16=__hip_bfloat16;
using bf16x8=__attribute__((ext_vector_type(8)))short;
using s16x4=__attribute__((ext_vector_type(4)))short;
using f32x16=__attribute__((ext_vector_type(16)))float;
using u32x4=__attribute__((ext_vector_type(4)))unsigned;
constexpr int SEQ=4096,D=64,QP=512,KP=128;
constexpr int NW=8,QBLK=32,QB=QBLK*NW,KVBLK=64,NQB=SEQ/QB;
__device__ __forceinline__ int crow(int r,int hi){return (r&3)+8*(r>>2)+4*hi;}
#define SBAR() __builtin_amdgcn_sched_barrier(0)
constexpr int NSLOT=3, SLOTB=8192;
constexpr int LDS_K=0, LDS_V=NSLOT*SLOTB, LDS_WS=2*NSLOT*SLOTB, LDS_OST=LDS_WS+NW*64*4, LDS_BYTES=LDS_OST+NW*4096;
constexpr float C2=0.125f*1.4426950408889634f;
__device__ __forceinline__ void glds16(const void*gsrc,unsigned lds_dst){unsigned keep;
  asm volatile("s_mov_b32 %0, m0\n\ts_mov_b32 m0, %2\n\ts_nop 0\n\tglobal_load_lds_dwordx4 %1, off\n\ts_mov_b32 m0, %0":"=&s"(keep):"v"(gsrc),"s"(lds_dst):"memory");}
__device__ __forceinline__ float max3f(float a,float b,float c){float r;asm("v_max3_f32 %0, %1, %2, %3":"=v"(r):"v"(a),"v"(b),"v"(c));return r;}
__device__ __forceinline__ float max2f(float a,float b){float r;asm("v_max_f32_e32 %0, %1, %2":"=v"(r):"v"(a),"v"(b));return r;}
__device__ __forceinline__ float fadd_s(float a,float b){float r;asm("v_add_f32_e32 %0, %1, %2":"=v"(r):"v"(a),"v"(b));return r;}
__device__ __forceinline__ float fsub_s(float a,float b){float r;asm("v_sub_f32_e32 %0, %1, %2":"=v"(r):"v"(a),"v"(b));return r;}
typedef float f32x2_t __attribute__((ext_vector_type(2))); typedef __bf16 bf16x2_t __attribute__((ext_vector_type(2)));
__device__ __forceinline__ unsigned cvtpk_s(float lo,float hi){f32x2_t v={lo,hi};bf16x2_t b=__builtin_convertvector(v,bf16x2_t);return __builtin_bit_cast(unsigned,b);}
#define WAIT_BAR(N) asm volatile("s_waitcnt vmcnt(" #N ") lgkmcnt(0)\n\ts_barrier":::"memory")

__device__ __forceinline__ void qkt(f32x16&p0,f32x16&p1,const char*Kslot,const bf16x8*qr,const f32x16&negm,int r32,int hi){
  const char*kb=Kslot+hi*1024+r32*16;
  #pragma unroll
  for(int d0=0;d0<4;++d0){
    const bf16x8 b0=*reinterpret_cast<const bf16x8*>(kb+d0*2048);
    const bf16x8 b1=*reinterpret_cast<const bf16x8*>(kb+d0*2048+512);
    if(d0==0){p0=__builtin_amdgcn_mfma_f32_32x32x16_bf16(b0,qr[0],negm,0,0,0);p1=__builtin_amdgcn_mfma_f32_32x32x16_bf16(b1,qr[0],negm,0,0,0);}
    else{p0=__builtin_amdgcn_mfma_f32_32x32x16_bf16(b0,qr[d0],p0,0,0,0);p1=__builtin_amdgcn_mfma_f32_32x32x16_bf16(b1,qr[d0],p1,0,0,0);}}
}
typedef __attribute__((address_space(3))) const char* lds_cptr;
typedef short v4i16_t __attribute__((ext_vector_type(4)));
__device__ __forceinline__ void kload8(bf16x8*kf,lds_cptr kp){
  kf[0]=*(const __attribute__((address_space(3))) bf16x8*)(kp);      kf[1]=*(const __attribute__((address_space(3))) bf16x8*)(kp+512);
  kf[2]=*(const __attribute__((address_space(3))) bf16x8*)(kp+2048); kf[3]=*(const __attribute__((address_space(3))) bf16x8*)(kp+2560);
  kf[4]=*(const __attribute__((address_space(3))) bf16x8*)(kp+4096); kf[5]=*(const __attribute__((address_space(3))) bf16x8*)(kp+4608);
  kf[6]=*(const __attribute__((address_space(3))) bf16x8*)(kp+6144); kf[7]=*(const __attribute__((address_space(3))) bf16x8*)(kp+6656);
}
__device__ __forceinline__ void kload2(bf16x8*kf,lds_cptr kp,int j){ kf[2*j]=*(const __attribute__((address_space(3))) bf16x8*)(kp+j*2048); kf[2*j+1]=*(const __attribute__((address_space(3))) bf16x8*)(kp+j*2048+512); }
__device__ __forceinline__ s16x4 vtr(lds_cptr p){ return __builtin_bit_cast(s16x4,__builtin_amdgcn_ds_read_tr16_b64_v4i16((__attribute__((address_space(3))) v4i16_t*)p)); }
__device__ __forceinline__ float rowmax(const f32x16&p0,const f32x16&p1){
  float a=max3f(p0[0],p0[1],p1[0]),b=max3f(p0[2],p0[3],p1[1]);a=max3f(a,p1[2],p1[3]);
  #pragma unroll
  for(int r=4;r<16;r+=4){a=max3f(a,p0[r],p0[r+1]);b=max3f(b,p0[r+2],p0[r+3]);a=max3f(a,p1[r],p1[r+1]);b=max3f(b,p1[r+2],p1[r+3]);}
  const float m=max2f(a,b);
  auto rr=__builtin_amdgcn_permlane32_swap(__float_as_uint(m),__float_as_uint(m),false,false);
  return max2f(__uint_as_float(rr[0]),__uint_as_float(rr[1]));
}
__device__ __forceinline__ void pv(f32x16*o,int vb,bf16x8 pa0,bf16x8 pa1,bf16x8 pa2,bf16x8 pa3){
  #pragma unroll
  for(int d0=0;d0<2;++d0){s16x4 lo[4],hi[4];
    #pragma unroll
    for(int ks=0;ks<4;++ks){
      asm volatile("ds_read_b64_tr_b16 %0,%1 offset:%c2":"=&v"(lo[ks]):"v"(vb),"i"(d0*4096+ks*1024):"memory");
      asm volatile("ds_read_b64_tr_b16 %0,%1 offset:%c2":"=&v"(hi[ks]):"v"(vb),"i"(d0*4096+ks*1024+512):"memory");}
    asm volatile("s_waitcnt lgkmcnt(0)":::"memory");SBAR();
    #define PK(k) (bf16x8){lo[k][0],lo[k][1],lo[k][2],lo[k][3],hi[k][0],hi[k][1],hi[k][2],hi[k][3]}
    o[d0]=__builtin_amdgcn_mfma_f32_32x32x16_bf16(pa0,PK(0),o[d0],0,0,0);
    o[d0]=__builtin_amdgcn_mfma_f32_32x32x16_bf16(pa1,PK(1),o[d0],0,0,0);
    o[d0]=__builtin_amdgcn_mfma_f32_32x32x16_bf16(pa2,PK(2),o[d0],0,0,0);
    o[d0]=__builtin_amdgcn_mfma_f32_32x32x16_bf16(pa3,PK(3),o[d0],0,0,0);
    #undef PK
  }
}

#ifndef ATTN_STORE16
#define ATTN_STORE16(p,v) (*(u32x4*)(p)=(v))
#endif
template<int THRL> __device__ __forceinline__ void attn_unit(int b,int h,int hkv,int qb,const bf16*Q,const bf16*__restrict__ K,const bf16*__restrict__ V,bf16*O,char*shm,float sbound){
  const int tid=opaque_tid(),lane=tid&63,r32=lane&31,hi=lane>>5; const int wid=__builtin_amdgcn_readfirstlane(tid>>6);
  const long rowbase=(long)b*SEQ; const int q0=qb*QB;
  const bf16*Qw=Q+(rowbase+q0+wid*QBLK)*QP+h*D;
  const bf16*Kh=K+rowbase*KP+hkv*D,*Vh=V+rowbase*KP+hkv*D;
  const unsigned lds0=(unsigned)(uintptr_t)shm;
  float*wsf=(float*)(shm+LDS_WS)+wid*64;
  const bf16*ksrc=Kh+(long)lane*KP+wid*8;
  const bf16*vsrc=Vh+(long)(16*(wid&3)+(lane>>2))*KP+(wid>>2)*32+(lane&3)*8;
  const unsigned kdst=lds0+LDS_K+wid*1024, vdst=lds0+LDS_V+wid*1024;
  #define DMA_K(t,slot) glds16(ksrc+(long)(t)*KVBLK*KP,(unsigned)__builtin_amdgcn_readfirstlane(kdst+(slot)))
  #define DMA_V(t,slot) glds16(vsrc+(long)(t)*KVBLK*KP,(unsigned)__builtin_amdgcn_readfirstlane(vdst+(slot)))
  const int vb0=(int)(lds0+LDS_V)+((lane>>4)&1)*32+(lane&3)*8+(4*hi+((lane&15)>>2))*64;
  const char*Kbase=shm+LDS_K; bf16x8 kf[8];
  const lds_cptr shm3=(lds_cptr)shm; const lds_cptr kp0=shm3+LDS_K+hi*1024+r32*16; const lds_cptr vp0=shm3+LDS_V+((lane>>4)&1)*32+(lane&3)*8+(4*hi+((lane&15)>>2))*64;
  const int NT=SEQ/KVBLK;
  DMA_K(0,0);DMA_V(0,0);DMA_K(1,SLOTB);
  bf16x8 qr[4];
  #pragma unroll
  for(int d0=0;d0<4;++d0)qr[d0]=*reinterpret_cast<const bf16x8*>(&Qw[(long)r32*QP+d0*16+hi*8]);
  float mhat=0.f,l_reg=0.f;f32x16 o[2];o[0]=f32x16{};o[1]=f32x16{};f32x16 negm=f32x16{};
  if(THRL<0){ mhat=sbound; _Pragma("unroll") for(int r=0;r<16;++r)negm[r]=-sbound; }
  asm volatile("":"+v"(negm));
    #define CMASK(P0,P1,t) do{}while(0)
  bool resc=false;
  #define START(P0,P1) do{ resc=false; \
    if(THRL>=0){ const float rm=rowmax(P0,P1); const float dl=rm; mhat=fadd_s(mhat,dl); \
      _Pragma("unroll") for(int r=0;r<16;++r){P0[r]=fsub_s(P0[r],dl);P1[r]=fsub_s(P1[r],dl);} \
      _Pragma("unroll") for(int r=0;r<16;++r)negm[r]=-mhat; asm volatile("":"+v"(negm)); } \
    _Pragma("unroll") for(int r=0;r<16;++r)P0[r]=__builtin_amdgcn_exp2f(P0[r]); }while(0)
  #define RESC() do{ if(resc){ asm volatile("s_waitcnt lgkmcnt(0)":::"memory"); \
      _Pragma("unroll") for(int d_=0;d_<2;++d_) _Pragma("unroll") for(int r=0;r<16;++r)o[d_][r]*=wsf[crow(r,hi)]; } }while(0)
  f32x16 pA0,pA1,pB0,pB1;
  int sl_prev=0,sl_cur=0,sl_next=SLOTB;
  #define ROT() do{sl_prev=sl_cur;sl_cur=sl_next;sl_next=(sl_next==(NSLOT-1)*SLOTB)?0:sl_next+SLOTB;}while(0)
  DMA_K(2,2*SLOTB);
  WAIT_BAR(3);
  qkt(pA0,pA1,Kbase,qr,negm,r32,hi);asm volatile("s_nop 15\n\ts_nop 7":"+v"(pA0),"+v"(pA1));CMASK(pA0,pA1,0);
  START(pA0,pA1);
  _Pragma("unroll") for(int r=0;r<16;++r)pA1[r]=__builtin_amdgcn_exp2f(pA1[r]);
  WAIT_BAR(0);
  DMA_K(3,0);DMA_V(1,SLOTB);
  ROT();
  kload8(kf,kp0+sl_cur);
  WAIT_BAR(2);
  s16x4 vlo[8],vhi[8]; u32x4 pw0,pw1,pw2,pw3;
  #define PKW(P,B) cvtpk_s(P[B],P[B+1])
  #define PAF(k) __builtin_bit_cast(bf16x8,pw##k)
  #define VFR(i) (bf16x8){vlo[i][0],vlo[i][1],vlo[i][2],vlo[i][3],vhi[i][0],vhi[i][1],vhi[i][2],vhi[i][3]}
  #define PIN(x) asm volatile("":"+v"(x))
  #define MX3(a,b,c) __builtin_fmaxf(__builtin_fmaxf((a),(b)),(c))
  #define GAPA(MF,A0,A1,A2,A3,W0,W1,PW) do{ MF; sacc+=A0; sacc+=A1; sacc+=A2; sacc+=A3; PIN(sacc); W0; W1; PIN(PW); SBAR(); }while(0)
  #define EX(v) __builtin_amdgcn_exp2f(v)
  #define GAPB(MF,X,B) do{ MF; X[B]=EX(X[B]); X[B+1]=EX(X[B+1]); X[B+2]=EX(X[B+2]); X[B+3]=EX(X[B+3]); PIN(X); SBAR(); }while(0)
  #define VRD(i) do{ vlo[i]=vtr(vp_+(((i)>>2)*4096+((i)&3)*1024)); vhi[i]=vtr(vp_+(((i)>>2)*4096+((i)&3)*1024+512)); }while(0)
  #define KRD(G,j) do{ if(G){ kload2(kf,kp0+sl_next,j); SBAR(); } }while(0)
  #define STEP(C0,C1,P0,P1,t,GK,GV,GL) do{ SBAR(); \
    const lds_cptr vp_=vp0+sl_prev; \
    VRD(0); SBAR(); float sacc=(P0[0]+P0[1]); \
    GAPA(C0=__builtin_amdgcn_mfma_f32_32x32x16_bf16(kf[0],qr[0],negm,0,0,0), P0[2],P0[3],P0[4],P0[5],     pw0[0]=PKW(P0,0), pw0[1]=PKW(P0,2), pw0); \
    VRD(4); SBAR(); GAPA(C1=__builtin_amdgcn_mfma_f32_32x32x16_bf16(kf[1],qr[0],negm,0,0,0), P0[6],P0[7],P0[8],P0[9],     pw0[2]=PKW(P0,4), pw0[3]=PKW(P0,6), pw0); \
    VRD(1); SBAR(); GAPA(C0=__builtin_amdgcn_mfma_f32_32x32x16_bf16(kf[2],qr[1],C0,0,0,0),   P0[10],P0[11],P0[12],P0[13], pw1[0]=PKW(P0,8), pw1[1]=PKW(P0,10), pw1); \
    VRD(5); SBAR(); GAPA(C1=__builtin_amdgcn_mfma_f32_32x32x16_bf16(kf[3],qr[1],C1,0,0,0),   P0[14],P0[15],P1[0],P1[1],   pw1[2]=PKW(P0,12),pw1[3]=PKW(P0,14), pw1); \
    VRD(2); SBAR(); GAPA(C0=__builtin_amdgcn_mfma_f32_32x32x16_bf16(kf[4],qr[2],C0,0,0,0),   P1[2],P1[3],P1[4],P1[5],     pw2[0]=PKW(P1,0), pw2[1]=PKW(P1,2), pw2); \
    VRD(6); SBAR(); GAPA(C1=__builtin_amdgcn_mfma_f32_32x32x16_bf16(kf[5],qr[2],C1,0,0,0),   P1[6],P1[7],P1[8],P1[9],     pw2[2]=PKW(P1,4), pw2[3]=PKW(P1,6), pw2); \
    VRD(3); SBAR(); GAPA(C0=__builtin_amdgcn_mfma_f32_32x32x16_bf16(kf[6],qr[3],C0,0,0,0),   P1[10],P1[11],P1[12],P1[13], pw3[0]=PKW(P1,8), pw3[1]=PKW(P1,10), pw3); \
    VRD(7); SBAR(); GAPA(C1=__builtin_amdgcn_mfma_f32_32x32x16_bf16(kf[7],qr[3],C1,0,0,0),   P1[14],P1[15],0.f,0.f,       pw3[2]=PKW(P1,12),pw3[3]=PKW(P1,14), pw3); \
    l_reg+=sacc; \
    if(GK){DMA_K((t)+3,sl_cur);} if(GV){DMA_V((t)+1,sl_next);} \
    CMASK(C0,C1,t); \
    if(THRL>=0){ float a=MX3(C0[0],C0[1],C1[0]),b=MX3(C0[2],C0[3],C1[1]); a=MX3(a,C1[2],C1[3]); \
      _Pragma("unroll") for(int r=4;r<16;r+=4){a=MX3(a,C0[r],C0[r+1]);b=MX3(b,C0[r+2],C0[r+3]);a=MX3(a,C1[r],C1[r+1]);b=MX3(b,C1[r+2],C1[r+3]);} \
      float rm=__builtin_fmaxf(a,b); { auto rr=__builtin_amdgcn_permlane32_swap(__float_as_uint(rm),__float_as_uint(rm),false,false); rm=__builtin_fmaxf(__uint_as_float(rr[0]),__uint_as_float(rr[1])); } \
      resc=false; \
      if(__builtin_expect(__any(rm>(float)THRL),0)){ const float dl=__builtin_fmaxf(rm,0.f); mhat+=dl; \
        _Pragma("unroll") for(int r=0;r<16;++r){C0[r]-=dl;C1[r]-=dl;} \
        _Pragma("unroll") for(int r=0;r<16;++r)negm[r]=-mhat; asm volatile("":"+v"(negm)); \
        const float f=__builtin_amdgcn_exp2f(-dl); l_reg*=f; if(hi==0)wsf[r32]=f; resc=true; } } \
    SBAR(); \
    GAPB(o[0]=__builtin_amdgcn_mfma_f32_32x32x16_bf16(PAF(0),VFR(0),o[0],0,0,0), C0,0); \
    GAPB(o[1]=__builtin_amdgcn_mfma_f32_32x32x16_bf16(PAF(0),VFR(4),o[1],0,0,0), C0,4); \
    KRD(GL,0); GAPB(o[0]=__builtin_amdgcn_mfma_f32_32x32x16_bf16(PAF(1),VFR(1),o[0],0,0,0), C0,8); \
    KRD(GL,1); GAPB(o[1]=__builtin_amdgcn_mfma_f32_32x32x16_bf16(PAF(1),VFR(5),o[1],0,0,0), C0,12); \
    KRD(GL,2); GAPB(o[0]=__builtin_amdgcn_mfma_f32_32x32x16_bf16(PAF(2),VFR(2),o[0],0,0,0), C1,0); \
    KRD(GL,3); GAPB(o[1]=__builtin_amdgcn_mfma_f32_32x32x16_bf16(PAF(2),VFR(6),o[1],0,0,0), C1,4); \
    GAPB(o[0]=__builtin_amdgcn_mfma_f32_32x32x16_bf16(PAF(3),VFR(3),o[0],0,0,0), C1,8); \
    GAPB(o[1]=__builtin_amdgcn_mfma_f32_32x32x16_bf16(PAF(3),VFR(7),o[1],0,0,0), C1,12); \
    }while(0)
  int t=1;
  #undef CMASK
  #define CMASK(P0,P1,t) do{}while(0)
  for(;t+5<NT;t+=2){
    STEP(pB0,pB1,pA0,pA1,t,true,true,true);     WAIT_BAR(2); RESC(); ROT();
    STEP(pA0,pA1,pB0,pB1,t+1,true,true,true);   WAIT_BAR(2); RESC(); ROT();
  }
  #undef CMASK
  #define CMASK(P0,P1,t) do{}while(0)
  #define ENDW(tt) do{ if((tt)+3<NT){WAIT_BAR(2);} else if((tt)+2<NT){WAIT_BAR(1);} else {WAIT_BAR(0);} }while(0)
  for(;t+1<NT;t+=2){
    STEP(pB0,pB1,pA0,pA1,t,(t+3<NT),(t+1<NT),(t+1<NT));       ENDW(t);   RESC(); ROT();
    STEP(pA0,pA1,pB0,pB1,t+1,(t+4<NT),(t+2<NT),(t+2<NT));     ENDW(t+1); RESC(); ROT();
  }
  STEP(pB0,pB1,pA0,pA1,NT-1,false,false,false); RESC();
  { float sacc=pB0[0]+pB0[1]; _Pragma("unroll") for(int r=2;r<16;++r)sacc+=pB0[r]; _Pragma("unroll") for(int r=0;r<16;++r)sacc+=pB1[r]; l_reg+=sacc;
    pw0=(u32x4){PKW(pB0,0),PKW(pB0,2),PKW(pB0,4),PKW(pB0,6)};pw1=(u32x4){PKW(pB0,8),PKW(pB0,10),PKW(pB0,12),PKW(pB0,14)};pw2=(u32x4){PKW(pB1,0),PKW(pB1,2),PKW(pB1,4),PKW(pB1,6)};pw3=(u32x4){PKW(pB1,8),PKW(pB1,10),PKW(pB1,12),PKW(pB1,14)};
    SBAR(); pv(o,vb0+sl_cur,PAF(0),PAF(1),PAF(2),PAF(3)); }
  #undef PKW
  #undef PAF
  #undef VFR
  #undef PIN
  #undef MX3
  #undef GAPA
  #undef GAPB
  #undef EX
  #undef VRD
  #undef KRD
  #undef STEP
  #undef ENDW
  {auto rr=__builtin_amdgcn_permlane32_swap(__float_as_uint(l_reg),__float_as_uint(l_reg),false,false);l_reg=__uint_as_float(rr[0])+__uint_as_float(rr[1]);}
  if(hi==0)wsf[32+r32]=l_reg;asm volatile("s_waitcnt lgkmcnt(0)":::"memory");
  float rli[16];
  #pragma unroll
  for(int r=0;r<16;++r)rli[r]=__builtin_amdgcn_rcpf(wsf[32+crow(r,hi)]);
  bf16*Ow=O+(rowbase+q0+wid*QBLK)*QP+h*D;
  { bf16*stg=(bf16*)(shm+LDS_OST)+wid*2048;
    #pragma unroll
    for(int r=0;r<16;++r){const int orow=crow(r,hi);
      #pragma unroll
      for(int d0=0;d0<2;++d0)stg[orow*64+d0*32+r32]=__float2bfloat16(o[d0][r]*rli[r]);}
    asm volatile("s_waitcnt lgkmcnt(0)":::"memory");
    #pragma unroll
    for(int i=0;i<4;++i){const int row=i*8+(lane>>3),ch=lane&7; const u32x4 v=*(const u32x4*)(stg+row*64+ch*8); ATTN_STORE16(Ow+(long)row*QP+ch*8,v);} }
  asm volatile("s_waitcnt lgkmcnt(0)\n\ts_barrier":::"memory");
  #undef DMA_K
  #undef DMA_V
  #undef CMASK
  #undef START
  #undef RESC
  #undef ROT
}
constexpr int ATTN_LDS_BYTES=LDS_BYTES;
template<int THRL=8> __device__ __forceinline__ void attn_phase(char*lds,const bf16*Q,const bf16*K,const bf16*V,bf16*O,float sbound){
  const int G=gridDim.x,bx=blockIdx.x; const int v=(G%8==0)?(bx%8)*(G/8)+bx/8:bx;
  for(int u=v;u<512;u+=G){ const int un=(G==256)?((u&255)*2+(u>>8)):u;
    const int pair=un>>6,loc=un&63,b=pair>>1,hkv=pair&1,h=hkv*4+(loc>>4),qb=loc&15;
    attn_unit<THRL>(b,h,hkv,qb,Q,K,V,O,lds,sbound); }
}
#undef SBAR
#undef WAIT_BAR
}

__device__ __forceinline__ void phase_attn_naive(const Params& p, float* lds) {
    const int tid = opaque_tid();
    const bf16_t* QB = (const bf16_t*)(p.ws + WS_QB); const bf16_t* KB = (const bf16_t*)(p.ws + WS_KB); const bf16_t* VB = (const bf16_t*)(p.ws + WS_VB);
    bf16_t* AO = (bf16_t*)(p.ws + WS_AO);
    float* Ks = lds; float* Vs = lds + 64 * 64;
    const int half = tid & 1;
    for (int it = blockIdx.x; it < 512; it += gridDim.x) {
        const int b = it >> 7, hq = (it >> 4) & 7, ch = it & 15, hkv = hq >> 2;
        const int m = b * 4096 + ch * 256 + (tid >> 1);
        float q[64], o[32];
        {
            const v4u* qp = (const v4u*)(QB + (size_t)m * 512 + hq * 64);
#pragma unroll
            for (int i = 0; i < 8; ++i) { const v4u w = qp[i]; q[i * 8 + 0] = lo16(w.x); q[i * 8 + 1] = hi16(w.x); q[i * 8 + 2] = lo16(w.y); q[i * 8 + 3] = hi16(w.y); q[i * 8 + 4] = lo16(w.z); q[i * 8 + 5] = hi16(w.z); q[i * 8 + 6] = lo16(w.w); q[i * 8 + 7] = hi16(w.w); }
        }
#pragma unroll
        for (int d = 0; d < 32; ++d) o[d] = 0.f;
        float mx = -1e30f, lsum = 0.f;
        for (int kt = 0; kt < 64; ++kt) {
            __syncthreads();
            {
                const int key = tid >> 3, d8 = (tid & 7) * 8;
                const size_t off = (size_t)(b * 4096 + kt * 64 + key) * 128 + hkv * 64 + d8;
                const v4u kw = *(const v4u*)(KB + off), vw = *(const v4u*)(VB + off);
                float* kd = Ks + key * 64 + d8; float* vd = Vs + key * 64 + d8;
                kd[0] = lo16(kw.x); kd[1] = hi16(kw.x); kd[2] = lo16(kw.y); kd[3] = hi16(kw.y); kd[4] = lo16(kw.z); kd[5] = hi16(kw.z); kd[6] = lo16(kw.w); kd[7] = hi16(kw.w);
                vd[0] = lo16(vw.x); vd[1] = hi16(vw.x); vd[2] = lo16(vw.y); vd[3] = hi16(vw.y); vd[4] = lo16(vw.z); vd[5] = hi16(vw.z); vd[6] = lo16(vw.w); vd[7] = hi16(vw.w);
            }
            __syncthreads();
#pragma unroll 1
            for (int j = 0; j < 64; ++j) {
                float a0 = 0.f, a1 = 0.f; const float* kr = Ks + j * 64;
#pragma unroll
                for (int d = 0; d < 64; d += 8) {
                    const f32x4 kv = *(const f32x4*)(kr + d), kw = *(const f32x4*)(kr + d + 4);
                    a0 += q[d] * kv.x + q[d + 1] * kv.y + q[d + 2] * kv.z + q[d + 3] * kv.w; a1 += q[d + 4] * kw.x + q[d + 5] * kw.y + q[d + 6] * kw.z + q[d + 7] * kw.w;
                }
                const float sc = a0 + a1;
                if (sc > mx) {
                    const float corr = exp2f(mx - sc); lsum *= corr;
#pragma unroll
                    for (int d = 0; d < 32; ++d) o[d] *= corr;
                    mx = sc;
                }
                const float pj = exp2f(sc - mx); lsum += pj; const float* vr = Vs + j * 64 + half * 32;
#pragma unroll
                for (int d = 0; d < 32; d += 4) { const f32x4 vv = *(const f32x4*)(vr + d); o[d] += pj * vv.x; o[d + 1] += pj * vv.y; o[d + 2] += pj * vv.z; o[d + 3] += pj * vv.w; }
            }
        }
        const float il = 1.0f / lsum;
        v4u* op = (v4u*)(AO + (size_t)m * 512 + hq * 64 + half * 32);
#pragma unroll
        for (int i = 0; i < 4; ++i) { v4u w; w.x = pk2(o[i * 8] * il, o[i * 8 + 1] * il); w.y = pk2(o[i * 8 + 2] * il, o[i * 8 + 3] * il); w.z = pk2(o[i * 8 + 4] * il, o[i * 8 + 5] * il); w.w = pk2(o[i * 8 + 6] * il, o[i * 8 + 7] * il); op[i] = w; }
    }
}


struct SsmConst { double lr, li, dt; float fre, fim; };
__device__ __forceinline__ void ssm_const(const Params& p, size_t gi, int pp, SsmConst& c) {
    c.lr = (double)p.lam_re[gi * 64 + pp]; c.li = (double)p.lam_im[gi * 64 + pp]; c.dt = exp((double)p.log_dt[gi]);
    const double mag = exp(c.lr * c.dt), ar = mag * cos(c.li * c.dt), ai = mag * sin(c.li * c.dt);
    const double nr = ar - 1.0, ni = ai, den = c.lr * c.lr + c.li * c.li;
    c.fre = (float)((nr * c.lr + ni * c.li) / den); c.fim = (float)((ni * c.lr - nr * c.li) / den);
}
__device__ __forceinline__ void cpow_lam(const SsmConst& c, int k, float& re, float& im) {
    const double rev = (double)k * c.li * c.dt * 0.15915494309189533576888376337251, fr = rev - rint(rev);
    const float mag = __expf((float)((double)k * c.lr * c.dt));
    re = mag * __builtin_amdgcn_cosf((float)fr); im = mag * __builtin_amdgcn_sinf((float)fr);
}
__device__ __forceinline__ void pro_ssm_gt(const Params& p, float* lds) {
    const int tid = opaque_tid();
    float* APs = lds;
    float* Bbs = lds + 2048;
    float* Cs = lds + 4096;
    float* GT = (float*)(p.ws + WS_GT);
    constexpr int NKQ = CL / 16;
    for (int it = blockIdx.x; it < 2 * 32 * 2 * NKQ; it += gridDim.x) {
        const int kq = it % NKQ, dir = (it / NKQ) & 1, g = (it / (2 * NKQ)) & 31, l = it / (64 * NKQ);
        const size_t gi = (size_t)(l * 2 + dir) * 32 + g;
        SsmConst* CS = (SsmConst*)(lds + 6144);
        __syncthreads();
        if (tid < 64) { SsmConst c; ssm_const(p, gi, tid, c); CS[tid] = c; }
        __syncthreads();
        for (int e = tid; e < 1024; e += NTHREADS) {
            const int pp = e >> 4, q = e & 15; const SsmConst c = CS[pp];
            float re, im; cpow_lam(c, kq * 16 + q, re, im); APs[2 * e] = re; APs[2 * e + 1] = im;
            const float br = p.b_re[(gi * 64 + pp) * 16 + q], bi = p.b_im[(gi * 64 + pp) * 16 + q];
            Bbs[2 * e] = c.fre * br - c.fim * bi; Bbs[2 * e + 1] = c.fre * bi + c.fim * br;
            Cs[2 * e] = p.c_re[gi * 1024 + e]; Cs[2 * e + 1] = p.c_im[gi * 1024 + e];
        }
        __syncthreads();
        const int cc = tid & 255, co = cc >> 4, ci = cc & 15, kh = tid >> 8;
        float acc[8];
#pragma unroll
        for (int k = 0; k < 8; ++k) acc[k] = 0.f;
        for (int pp = 0; pp < 64; ++pp) {
            const float cr = Cs[2 * (co * 64 + pp)], cim = Cs[2 * (co * 64 + pp) + 1], br = Bbs[2 * (pp * 16 + ci)], bi = Bbs[2 * (pp * 16 + ci) + 1];
            const float cbr = cr * br - cim * bi, cbi = cr * bi + cim * br;
#pragma unroll
            for (int k = 0; k < 8; ++k) { const float ar = APs[2 * (pp * 16 + kh * 8 + k)], ai = APs[2 * (pp * 16 + kh * 8 + k) + 1]; acc[k] += cbr * ar - cbi * ai; }
        }
#pragma unroll
        for (int k = 0; k < 8; ++k) GT[((gi * CL) + kq * 16 + kh * 8 + k) * 256 + cc] = acc[k];
    }
    __syncthreads();
}
__device__ __forceinline__ void pro_ssm_expand(const Params& p, float* lds) {
    const int tid = opaque_tid();
    constexpr int APL = CL + 1, TB = CL / 4, W2 = CL * 2;
    float* AP = lds;
    float* Bb = lds + 2 * 64 * APL * 2;
    float* Cc = Bb + 2 * 64 * 16 * 2;
    const float* GT = (const float*)(p.ws + WS_GT);
    bf16_t* SM = (bf16_t*)(p.ws + WS_SSMM); bf16_t* SS = (bf16_t*)(p.ws + WS_SSMS); float* AL = (float*)(p.ws + WS_AL);
    for (int it = blockIdx.x; it < 256; it += gridDim.x) {
        const int tq = it & 3, g = (it >> 2) & 31, l = it >> 7, lg = l * 32 + g;
        SsmConst* CS = (SsmConst*)(Cc + 2 * 16 * 64 * 2);
        __syncthreads();
        if (tid < 128) { SsmConst c; ssm_const(p, (size_t)(l * 2 + (tid >> 6)) * 32 + g, tid & 63, c); CS[tid] = c; }
        __syncthreads();
        for (int e = tid; e < 2 * 64 * APL; e += NTHREADS) {
            const int dp = e / APL, k = e % APL;
            float re, im; cpow_lam(CS[dp], k, re, im); AP[2 * e] = re; AP[2 * e + 1] = im;
        }
        for (int e = tid; e < 2048; e += NTHREADS) {
            const int dir = e >> 10, r = e & 1023, pp = r >> 4, ci = r & 15;
            const size_t gi = (size_t)(l * 2 + dir) * 32 + g; const SsmConst c = CS[dir * 64 + pp];
            const float br = p.b_re[(gi * 64 + pp) * 16 + ci], bi = p.b_im[(gi * 64 + pp) * 16 + ci];
            Bb[2 * e] = c.fre * br - c.fim * bi; Bb[2 * e + 1] = c.fre * bi + c.fim * br;
            Cc[2 * e] = p.c_re[gi * 1024 + r]; Cc[2 * e + 1] = p.c_im[gi * 1024 + r];
        }
        __syncthreads();
        if (tq == 0 && tid < 128) { const int dir = tid >> 6, pp = tid & 63; const int e = (dir * 64 + pp) * APL + CL; AL[((size_t)(lg * 2 + dir) * 64 + pp) * 2] = AP[2 * e]; AL[((size_t)(lg * 2 + dir) * 64 + pp) * 2 + 1] = AP[2 * e + 1]; }
        const float* __restrict__ GTf = GT + ((size_t)(l * 2 + 0) * 32 + g) * CL * 256; const float* __restrict__ GTb = GT + ((size_t)(l * 2 + 1) * 32 + g) * CL * 256;
        for (int w0 = tid; w0 < TB * 16 * W2; w0 += 4 * NTHREADS) {
            f32x4 v0[4], v1[4]; int tt[4], ss[4], cc[4], hh[4];
#pragma unroll
            for (int u = 0; u < 4; ++u) {
                const int w = w0 + u * NTHREADS, rl = w / W2, within = w % W2, s_ = within >> 1, hf = within & 1, t = tq * TB + (rl >> 4), co = rl & 15;
                tt[u] = t; ss[u] = s_; cc[u] = co; hh[u] = hf;
                const int lf = t >= s_ ? t - s_ : 0, lb = s_ >= t ? s_ - t : 0;
                const float* qf = GTf + (size_t)lf * 256 + co * 16 + hf * 8; const float* qb = GTb + (size_t)lb * 256 + co * 16 + hf * 8;
                const f32x4 f0 = *(const f32x4*)qf, f1 = *(const f32x4*)(qf + 4), b0 = *(const f32x4*)qb, b1 = *(const f32x4*)(qb + 4);
                const float mf = t >= s_ ? 1.f : 0.f, mb = s_ >= t ? 1.f : 0.f;
                v0[u] = f0 * mf + b0 * mb; v1[u] = f1 * mf + b1 * mb;
            }
#pragma unroll
            for (int u = 0; u < 4; ++u) {
                const int t = tt[u], s_ = ss[u], co = cc[u], hf = hh[u];
                if (t == s_ && (co >> 3) == hf) {
                    const float dv = p.ssm_d[l * 512 + g * 16 + co]; const int j = co & 7;
                    if (j == 0) v0[u].x += dv; else if (j == 1) v0[u].y += dv; else if (j == 2) v0[u].z += dv; else if (j == 3) v0[u].w += dv;
                    else if (j == 4) v1[u].x += dv; else if (j == 5) v1[u].y += dv; else if (j == 6) v1[u].z += dv; else v1[u].w += dv;
                }
                *(v4u*)(SM + ((size_t)lg * CU + t * 16 + co) * UXW + s_ * 16 + hf * 8) = pack8(v0[u], v1[u]);
            }
        }
        for (int w = tid; w < TB * 16 * 32; w += NTHREADS) {
            const int rl = w >> 5, j0 = (w & 31) * 8, t = tq * TB + (rl >> 4), co = rl & 15, dir = j0 >> 7, p0 = (j0 & 127) >> 1, ex = dir ? CL - t : t + 1;
            float o[8];
#pragma unroll
            for (int q = 0; q < 4; ++q) {
                const int pp = p0 + q; const float cr = Cc[2 * ((dir * 16 + co) * 64 + pp)], cim = Cc[2 * ((dir * 16 + co) * 64 + pp) + 1];
                const float ar = AP[2 * ((dir * 64 + pp) * APL + ex)], ai = AP[2 * ((dir * 64 + pp) * APL + ex) + 1];
                o[2 * q] = cr * ar - cim * ai; o[2 * q + 1] = -(cr * ai + cim * ar);
            }
            v4u pk; pk.x = pk2(o[0], o[1]); pk.y = pk2(o[2], o[3]); pk.z = pk2(o[4], o[5]); pk.w = pk2(o[6], o[7]);
            *(v4u*)(SM + ((size_t)lg * CU + t * 16 + co) * UXW + CU + j0) = pk;
        }
        for (int w = tid; w < 64 * W2; w += NTHREADS) {
            const int j = tq * 64 + w / W2, within = w % W2, s = within >> 1, hf = within & 1, dir = j >> 7, pp = (j & 127) >> 1, ri = j & 1, ex = dir ? s : CL - 1 - s;
            const float ar = AP[2 * ((dir * 64 + pp) * APL + ex)], ai = AP[2 * ((dir * 64 + pp) * APL + ex) + 1];
            float o[8];
#pragma unroll
            for (int q = 0; q < 8; ++q) { const float br = Bb[2 * ((dir * 64 + pp) * 16 + hf * 8 + q)], bi = Bb[2 * ((dir * 64 + pp) * 16 + hf * 8 + q) + 1]; o[q] = ri ? (ar * bi + ai * br) : (ar * br - ai * bi); }
            v4u pk; pk.x = pk2(o[0], o[1]); pk.y = pk2(o[2], o[3]); pk.z = pk2(o[4], o[5]); pk.w = pk2(o[6], o[7]);
            *(v4u*)(SS + ((size_t)lg * 256 + j) * CU + s * 16 + hf * 8) = pk;
        }
    }
}
__device__ __forceinline__ void ssm_scan_unit(const Params& p, int l, int unit) {
    const float* SLOC = (const float*)(p.ws + WS_SLOC); const float* AL = (const float*)(p.ws + WS_AL); bf16_t* UX = (bf16_t*)(p.ws + WS_UX);
    const int i = opaque_tid();
    if (i >= 256) return;
    const int g = unit >> 1, pp = i & 63, dir = (i >> 6) & 1, b = (unit & 1) * 2 + ((i >> 7) & 1);
    const float ar = AL[((size_t)((l * 32 + g) * 2 + dir) * 64 + pp) * 2], ai = AL[((size_t)((l * 32 + g) * 2 + dir) * 64 + pp) * 2 + 1];
    float xr = 0.f, xi = 0.f;
    const float* sb = SLOC + ((size_t)g * RG + b * NCH) * 256 + dir * 128 + 2 * pp;
    constexpr int SW = 64;
    typedef float f32x2_ __attribute__((ext_vector_type(2)));
    f32x2_ win[SW];
#pragma unroll
    for (int j = 0; j < SW; ++j) { const int c = dir ? NCH - 1 - j : j; win[j] = *(const f32x2_*)(sb + (size_t)c * 256); }
#pragma unroll
    for (int j = 0; j < NCH; ++j) {
        const int c = dir ? NCH - 1 - j : j; const size_t row = (size_t)g * RG + b * NCH + c;
        const f32x2_ sv = win[j % SW];
        if (j + SW < NCH) { const int c2 = dir ? NCH - 1 - (j + SW) : j + SW; win[j % SW] = *(const f32x2_*)(sb + (size_t)c2 * 256); }
        *(unsigned*)(UX + row * UXW + CU + dir * 128 + 2 * pp) = pk2(xr, xi);
        const float nr = ar * xr - ai * xi + sv.x, ni = ar * xi + ai * xr + sv.y; xr = nr; xi = ni;
    }
}
__device__ __forceinline__ void phase_ssm_scan(const Params& p, int l) { for (int u = blockIdx.x; u < 64; u += gridDim.x) ssm_scan_unit(p, l, u); }
__device__ __forceinline__ void phase_ssm_naive(const Params& p, int l) {
    const int tid = opaque_tid(), w = tid >> 6, lane = tid & 63;
    const int gw = blockIdx.x * NWAVES + w, NGW = gridDim.x * NWAVES;
    const bf16_t* UX = (const bf16_t*)(p.ws + WS_UX);
    float* YP = (float*)(p.ws + WS_YP);
    for (int it = gw; it < 256; it += NGW) {
        const int b = it >> 6, g = (it >> 1) & 31, dir = it & 1;
        const size_t gi = (size_t)(l * 2 + dir) * 32 + g, pi = gi * 64 + lane;
        const float lr = p.lam_re[pi], li = p.lam_im[pi], dt = expf(p.log_dt[gi]);
        const float mag = expf(lr * dt), ar = mag * cosf(li * dt), ai = mag * sinf(li * dt);
        const float nr = ar - 1.0f, ni = ai, den = lr * lr + li * li;
        const float fr = (nr * lr + ni * li) / den, fi = (ni * lr - nr * li) / den;
        float bbr[16], bbi[16], cr[16], ci[16];
#pragma unroll
        for (int c = 0; c < 16; ++c) {
            const float br = p.b_re[pi * 16 + c], bi = p.b_im[pi * 16 + c];
            bbr[c] = fr * br - fi * bi; bbi[c] = fr * bi + fi * br;
            cr[c] = p.c_re[(gi * 16 + c) * 64 + lane]; ci[c] = p.c_im[(gi * 16 + c) * 64 + lane];
        }
        float xr = 0.f, xi = 0.f;
        const bf16_t* ub = UX + ((size_t)g * 256 + b * 64) * UXW;
        int t = dir ? 4095 : 0;
        const v4u* up = (const v4u*)(ub + (size_t)(t >> 6) * UXW + (t & 63) * 16);
        v4u n0 = up[0], n1 = up[1];
        for (int s = 0; s < 4096; ++s) {
            const v4u u0 = n0, u1 = n1;
            const int tn = dir ? (t > 0 ? t - 1 : 0) : (t < 4095 ? t + 1 : 4095);
            const v4u* upn = (const v4u*)(ub + (size_t)(tn >> 6) * UXW + (tn & 63) * 16);
            n0 = upn[0]; n1 = upn[1];
            const float u[16] = {lo16(u0.x), hi16(u0.x), lo16(u0.y), hi16(u0.y), lo16(u0.z), hi16(u0.z), lo16(u0.w), hi16(u0.w),
                                 lo16(u1.x), hi16(u1.x), lo16(u1.y), hi16(u1.y), lo16(u1.z), hi16(u1.z), lo16(u1.w), hi16(u1.w)};
            float bur = 0.f, bui = 0.f;
#pragma unroll
            for (int c = 0; c < 16; ++c) { bur += bbr[c] * u[c]; bui += bbi[c] * u[c]; }
            const float nxr = ar * xr - ai * xi + bur, nxi = ar * xi + ai * xr + bui; xr = nxr; xi = nxi;
            float mine = 0.f;
#pragma unroll
            for (int c = 0; c < 16; ++c) { float v = cr[c] * xr - ci[c] * xi; v = wave_sum(v, lane); if (lane == c) mine = v; }
            if (lane < 16) YP[((size_t)dir * T + b * 4096 + t) * 512 + g * 16 + lane] = mine;
            t = tn;
        }
    }
}
__device__ __forceinline__ void phase_ssmpost_naive(const Params& p, int l) {
    const bf16_t* UX = (const bf16_t*)(p.ws + WS_UX); const float* YP = (const float*)(p.ws + WS_YP); bf16_t* Z = (bf16_t*)(p.ws + WS_Z);
    const int total = T * 512;
    for (int i = blockIdx.x * NTHREADS + opaque_tid(); i < total; i += gridDim.x * NTHREADS) {
        const int m = i >> 9, ch = i & 511, b = m >> 12, t = m & 4095, g = ch >> 4, co = ch & 15;
        const float u = bf2f(UX[((size_t)g * 256 + b * 64 + (t >> 6)) * UXW + (t & 63) * 16 + co]);
        const float y = YP[(size_t)m * 512 + ch] + YP[((size_t)T + m) * 512 + ch] + p.ssm_d[l * 512 + ch] * u;
        Z[(size_t)m * 512 + ch] = (bf16_t)f2bf(gelu_tanh(y));
    }
}

__device__ __forceinline__ void phase_topk(const Params& p, float* lds) {
    const int tid = opaque_tid(), lane = tid & 63, w = tid >> 6;
    const float* AFF = (const float*)(p.ws + WS_AFF);
    int* IDX = (int*)(p.ws + WS_IDX); float* GATE = (float*)(p.ws + WS_GATE); int* INV = (int*)(p.ws + WS_INV); int* SRC = (int*)(p.ws + WS_SRC);
    unsigned* hist = (unsigned*)lds;
    unsigned* misc = hist + 1024;
    for (int be = blockIdx.x; be < 64; be += gridDim.x) {
        const int b = be >> 4, e = be & 15;
        const f32x4 va = *(const f32x4*)(AFF + (size_t)be * 4096 + tid * 8), vb = *(const f32x4*)(AFF + (size_t)be * 4096 + tid * 8 + 4);
        const float val[8] = {va.x, va.y, va.z, va.w, vb.x, vb.y, vb.z, vb.w};
        unsigned key[8];
#pragma unroll
        for (int i = 0; i < 8; ++i) key[i] = __float_as_uint(val[i]);
        unsigned prefix = 0u, kk = CAP;
#pragma unroll 1
        for (int pass = 0; pass < 3; ++pass) {
            const int shift = 20 - 10 * pass;
            __syncthreads();
            hist[tid] = 0u; hist[tid + 512] = 0u;
            __syncthreads();
#pragma unroll
            for (int i = 0; i < 8; ++i) if (pass == 0 || (key[i] >> (shift + 10)) == prefix) atomicAdd(&hist[(key[i] >> shift) & 1023u], 1u);
            __syncthreads();
            const unsigned h0 = hist[2 * tid], h1 = hist[2 * tid + 1], mine = h0 + h1;
            unsigned inc = mine;
#pragma unroll
            for (int o = 1; o < 64; o <<= 1) { const unsigned y = (unsigned)__builtin_amdgcn_ds_bpermute(((lane + o) & 63) << 2, (int)inc); if (lane + o < 64) inc += y; }
            if (lane == 0) misc[16 + w] = inc;
            __syncthreads();
            {
                unsigned sfx = inc - mine;
                for (int w2 = w + 1; w2 < 8; ++w2) sfx += misc[16 + w2];
                if (sfx < kk && sfx + h1 >= kk) { misc[0] = (prefix << 10) | (unsigned)(2 * tid + 1); misc[1] = kk - sfx; }
                else if (sfx + h1 < kk && sfx + mine >= kk) { misc[0] = (prefix << 10) | (unsigned)(2 * tid); misc[1] = kk - sfx - h1; }
            }
            __syncthreads();
            prefix = misc[0]; kk = misc[1];
        }
        const unsigned thr = prefix;
        unsigned cg = 0u, ce = 0u;
#pragma unroll
        for (int i = 0; i < 8; ++i) { cg += key[i] > thr ? 1u : 0u; ce += key[i] == thr ? 1u : 0u; }
        const unsigned mineval = cg | (ce << 16);
        unsigned inc = mineval;
#pragma unroll
        for (int o = 1; o < 64; o <<= 1) { const unsigned y = (unsigned)__builtin_amdgcn_ds_bpermute(((lane - o) & 63) << 2, (int)inc); if (lane >= o) inc += y; }
        __syncthreads();
        if (lane == 63) misc[8 + w] = inc;
        __syncthreads();
        unsigned woff = 0u;
        for (int w2 = 0; w2 < w; ++w2) woff += misc[8 + w2];
        const unsigned excl = woff + inc - mineval;
        unsigned gb = excl & 0xffffu, eb = excl >> 16;
#pragma unroll
        for (int i = 0; i < 8; ++i) {
            const int t = tid * 8 + i; const bool isg = key[i] > thr, ise = key[i] == thr;
            const bool sel = isg || (ise && eb < kk);
            const unsigned slot = gb + (eb < kk ? eb : kk);
            if (sel) { IDX[be * 512 + slot] = t; GATE[be * 512 + slot] = val[i]; SRC[e * 2048 + b * 512 + slot] = b * 4096 + t; }
            INV[((size_t)b * 4096 + t) * 16 + e] = sel ? (int)slot : -1;
            gb += isg ? 1u : 0u; eb += ise ? 1u : 0u;
        }
    }
}
__device__ __forceinline__ void phase_gather(const Params& p) {
    const int tid = opaque_tid(), w = tid >> 6, lane = tid & 63;
    const int gw = blockIdx.x * NWAVES + w, NGW = gridDim.x * NWAVES;
    const bf16_t* H = (const bf16_t*)(p.ws + WS_H); bf16_t* XG = (bf16_t*)(p.ws + WS_XG); const int* IDX = (const int*)(p.ws + WS_IDX);
    for (int slot = gw; slot < NE * 2048; slot += NGW) {
        const int e = slot >> 11, r = slot & 2047, b = r >> 9, c = r & 511;
        const int tok = IDX[(b * 16 + e) * 512 + c];
        const v4u* src = (const v4u*)(H + ((size_t)b * 4096 + tok) * 1024); v4u* dst = (v4u*)(XG + (size_t)slot * 1024);
        dst[lane] = src[lane]; dst[lane + 64] = src[lane + 64];
    }
}
__device__ __forceinline__ void phase_combine(const Params& p, int l, float* XD) {
    const int tid = opaque_tid(), w = tid >> 6, lane = tid & 63;
    const int gw = blockIdx.x * NWAVES + w, NGW = gridDim.x * NWAVES;
    const bf16_t* YE = (const bf16_t*)(p.ws + WS_YE); const int* INV = (const int*)(p.ws + WS_INV);
    const bf16_t* ZROW = (const bf16_t*)(p.ws + WS_ZERO);
    const float* mod = (const float*)(p.ws + WS_MOD);
    bf16_t* H = (bf16_t*)(p.ws + WS_H);
    float* XR = p.out;
    const bool next = l + 1 < DEPTH;
    const float* lnw = p.ln1_w + (next ? (l + 1) * 1024 : 0);
    int cv = (gw < T) ? INV[(size_t)gw * 16 + (lane & 15)] : -1;
    for (int m = gw; m < T; m += NGW) {
        const int b = m >> 12;
        const int cur = cv; const int mn = m + NGW;
        if (mn < T) cv = INV[(size_t)mn * 16 + (lane & 15)];
        unsigned mask = (unsigned)__ballot(lane < 16 && cur >= 0) & 0xffffu;
        const bf16_t* rows[4];
#pragma unroll
        for (int k = 0; k < 4; ++k) {
            if (mask) { const int e = __builtin_ctz(mask); mask &= mask - 1u; const int c = __builtin_amdgcn_readlane(cur, e); rows[k] = YE + ((size_t)e * 2048 + b * 512 + c) * 1024; }
            else rows[k] = ZROW;
        }
        v2u rv[4][4];
#pragma unroll
        for (int k = 0; k < 4; ++k)
#pragma unroll
            for (int j = 0; j < 4; ++j) rv[k][j] = *(const v2u*)(rows[k] + j * 256 + lane * 4);
        f32x4 xv[4];
#pragma unroll
        for (int j = 0; j < 4; ++j) xv[j] = *(const f32x4*)(XR + (size_t)m * 1024 + j * 256 + lane * 4);
        float acc[16];
#pragma unroll
        for (int i = 0; i < 16; ++i) acc[i] = 0.f;
#pragma unroll
        for (int k = 0; k < 4; ++k)
#pragma unroll
            for (int j = 0; j < 4; ++j) { acc[j * 4] += lo16(rv[k][j].x); acc[j * 4 + 1] += hi16(rv[k][j].x); acc[j * 4 + 2] += lo16(rv[k][j].y); acc[j * 4 + 3] += hi16(rv[k][j].y); }
        while (mask) {
            const int e = __builtin_ctz(mask); mask &= mask - 1u; const int c = __builtin_amdgcn_readlane(cur, e);
            const bf16_t* row = YE + ((size_t)e * 2048 + b * 512 + c) * 1024;
#pragma unroll
            for (int j = 0; j < 4; ++j) { const v2u wv = *(const v2u*)(row + j * 256 + lane * 4); acc[j * 4] += lo16(wv.x); acc[j * 4 + 1] += hi16(wv.x); acc[j * 4 + 2] += lo16(wv.y); acc[j * 4 + 3] += hi16(wv.y); }
        }
        const float* g2 = mod + (size_t)(l * 4 + b) * 6144 + 5120;
        float ss = 0.f;
#pragma unroll
        for (int j = 0; j < 4; ++j) {
            const int col = j * 256 + lane * 4; const f32x4 gv = *(const f32x4*)(g2 + col);
            xv[j].x += gv.x * acc[j * 4]; xv[j].y += gv.y * acc[j * 4 + 1]; xv[j].z += gv.z * acc[j * 4 + 2]; xv[j].w += gv.w * acc[j * 4 + 3];
            *(f32x4*)(XD + (size_t)m * 1024 + col) = xv[j];
            ss += xv[j].x * xv[j].x + xv[j].y * xv[j].y + xv[j].z * xv[j].z + xv[j].w * xv[j].w;
        }
        if (next) {
            const float r = rsqrtf(wave_sum(ss, lane) * (1.0f / 1024.0f) + EPS);
            const float* modb = mod + (size_t)((l + 1) * 4 + b) * 6144;
#pragma unroll
            for (int j = 0; j < 4; ++j) {
                const int col = j * 256 + lane * 4;
                const f32x4 w4 = *(const f32x4*)(lnw + col), sh = *(const f32x4*)(modb + col), sc = *(const f32x4*)(modb + 1024 + col);
                const float h0 = xv[j].x * r * w4.x * (1.f + sc.x) + sh.x, h1 = xv[j].y * r * w4.y * (1.f + sc.y) + sh.y, h2 = xv[j].z * r * w4.z * (1.f + sc.z) + sh.z, h3 = xv[j].w * r * w4.w * (1.f + sc.w) + sh.w;
                v2u o; o.x = pk2(h0, h1); o.y = pk2(h2, h3);
                *(v2u*)(H + (size_t)m * 1024 + col) = o;
                if (INPROJ_FP8) *(unsigned*)((unsigned char*)(p.ws + WS_H8A) + (size_t)m * 1024 + col) = pk4_fp8(h0, h1, h2, h3);
            }
        }
    }
}

#define LAS __attribute__((address_space(3)))
#define XB_TMO      128
#define XB_XCNT(j)  (256  + 64 * (j))
#define XB_XSUB(j)  (1280 + 64 * (j))
#define XB_XGEN(j)  (2304 + 64 * (j))
#define XB_TOP      3328
#define XB_TOPGEN   3392
#define XCD_BAR_WORDS 3456
#define XB_SPIN_CAP (1u << 18)

__device__ __forceinline__ unsigned xb_ld(unsigned* p)              { return __hip_atomic_load(p, __ATOMIC_RELAXED, __HIP_MEMORY_SCOPE_AGENT); }
__device__ __forceinline__ unsigned xb_add(unsigned* p, unsigned v) { return __hip_atomic_fetch_add(p, v, __ATOMIC_RELAXED, __HIP_MEMORY_SCOPE_AGENT); }
__device__ __forceinline__ unsigned xb_xcc_id() { return (unsigned)__builtin_amdgcn_s_getreg((3 << 11) | 20) & 0xFu; }
#define XB_SPIN(cond, bar) do { unsigned _sp = 0; while (cond) { __builtin_amdgcn_s_sleep(1); \
    if ((++_sp & 255u) == 0u) { if (xb_ld(&(bar)[XB_TMO])) break; if (_sp > XB_SPIN_CAP) { atomicAdd(&(bar)[XB_TMO], 1u); break; } } } } while (0)

struct XcdBarrier {
    unsigned* bar; unsigned x;
    volatile LAS unsigned* st;
};

__device__ __forceinline__ XcdBarrier xcd_barrier_post(unsigned* bar, volatile LAS unsigned* st) {
    XcdBarrier b; b.bar = bar; b.x = xb_xcc_id(); b.st = st;
    if (threadIdx.x == 0) (void)xb_add(&bar[XB_XCNT(b.x)], 1u);
    return b;
}
__device__ __forceinline__ void xcd_barrier_complete(unsigned* bar, unsigned x, unsigned& nloc, unsigned& nx) {
    const unsigned G = gridDim.x * gridDim.y * gridDim.z;
    unsigned sum, cnt, mine, sp = 0u;
    for (;;) {
        sum = 0u; cnt = 0u; mine = 0u;
#pragma unroll
        for (unsigned j = 0; j < 16; ++j) { const unsigned c = xb_ld(&bar[XB_XCNT(j)]); sum += c; cnt += (c > 0u) ? 1u : 0u; mine = (j == x) ? c : mine; }
        if (sum == G) break;
        __builtin_amdgcn_s_sleep(1);
        if ((++sp & 255u) == 0u) { if (xb_ld(&bar[XB_TMO])) break; if (sp > XB_SPIN_CAP) { atomicAdd(&bar[XB_TMO], 1u); break; } }
    }
    nloc = mine > 0u ? mine : 1u; nx = cnt > 0u ? cnt : 1u;
}

#ifndef XB_EARLY
#define XB_EARLY 1
#endif
#if XB_EARLY
#define XB_EARLY_INV() asm volatile("buffer_inv sc1" ::: "memory")
#define XB_LATE_ACQ()  asm volatile("" ::: "memory")
#else
#define XB_EARLY_INV() do {} while (0)
#define XB_LATE_ACQ()  __builtin_amdgcn_fence(__ATOMIC_ACQUIRE, "agent")
#endif
__device__ __forceinline__ void xcd_barrier(const XcdBarrier& b) {
    asm volatile("s_waitcnt vmcnt(0)" ::: "memory");
    __syncthreads();
    if (threadIdx.x == 0) {
        unsigned* bar = b.bar;
        __builtin_amdgcn_s_waitcnt(0);
        unsigned nloc = b.st[0], nx = b.st[1];
        if (nloc == 0u) { xcd_barrier_complete(bar, b.st[2], nloc, nx); b.st[0] = nloc; b.st[1] = nx; }
        const unsigned bx_ = b.st[2];
        const unsigned old = xb_add(&bar[XB_XSUB(bx_)], 1u);
        const unsigned gen = old / nloc;
        if (old + 1u == (gen + 1u) * nloc) {
            __builtin_amdgcn_fence(__ATOMIC_RELEASE, "agent");
            asm volatile("s_waitcnt vmcnt(0)" ::: "memory");
            const unsigned og = xb_add(&bar[XB_TOP], 1u);
            const unsigned tg = og / nx;
            XB_EARLY_INV();
            if (og + 1u == (tg + 1u) * nx) xb_add(&bar[XB_TOPGEN], 1u);
            else XB_SPIN(xb_ld(&bar[XB_TOPGEN]) == tg, bar);
            XB_LATE_ACQ();
            xb_add(&bar[XB_XGEN(bx_)], 1u);
            asm volatile("s_waitcnt vmcnt(0)" ::: "memory");
        } else {
            XB_EARLY_INV();
            XB_SPIN(xb_ld(&bar[XB_XGEN(bx_)]) == gen, bar);
            XB_LATE_ACQ();
            asm volatile("s_waitcnt vmcnt(0)" ::: "memory");
        }
    }
    __syncthreads();
}

constexpr int LDS_MISC_OFF_C = 131072 + 64;
constexpr int CTL_CHAIN = 4096;
constexpr int CTL_WORDS = CTL_CHAIN + DEPTH * 3 * 64 * 64;
static_assert((size_t)CTL_WORDS * 4 <= WS_ZERO, "control words end below the zero row");
__device__ __forceinline__ unsigned* chain_ctr(const Params& p, int l, int stage, int pm) { return (unsigned*)(p.ws + WS_CTL) + CTL_CHAIN + ((l * 3 + stage) * 64 + pm) * 64; }
constexpr int CTL_XCCTAB = 3584;
__device__ __forceinline__ void chain_signal(unsigned* ctr, bool same_l2) {
    asm volatile("s_waitcnt vmcnt(0)" ::: "memory");
    __syncthreads();
    if (threadIdx.x == 0) {
        if (!same_l2) {
            __builtin_amdgcn_fence(__ATOMIC_RELEASE, "agent");
            asm volatile("s_waitcnt vmcnt(0)" ::: "memory");
        }
        __hip_atomic_fetch_add(ctr, 1u, __ATOMIC_RELAXED, __HIP_MEMORY_SCOPE_AGENT);
    }
}
__device__ __forceinline__ void chain_wait(unsigned* ctr, unsigned need) {
    if (threadIdx.x == 0) {
        unsigned spins = 0;
        XB_EARLY_INV();
        while (__hip_atomic_load(ctr, __ATOMIC_RELAXED, __HIP_MEMORY_SCOPE_AGENT) < need) { __builtin_amdgcn_s_sleep(2); if (++spins > (1u << 22)) break; }
        XB_LATE_ACQ();
        asm volatile("s_waitcnt vmcnt(0)" ::: "memory");
    }
    __syncthreads();
}
struct FixedUnit {
    int pm, pn; bool on;
    __device__ __forceinline__ bool next(int i, pg8::Unit& u) const { if (i > 0 || !on) return false; u.pm = pm; u.pn = pn; return true; }
    __device__ __forceinline__ void a_ready(const pg8::Unit&) const {}
    __device__ __forceinline__ void done(const pg8::Unit&) const {}
};
template <class Epi>
__device__ __forceinline__ void run_unit(float* lds, const bf16_t* A, int lda, const bf16_t* Bt, int ldb, int M, int N, int K, const FixedUnit& S, const Epi& e) {
    pg8::Gemm g{A, Bt, M, N, K, lda, ldb, 1 << 20, 0, nullptr, nullptr, nullptr};
    pg8::gemm_phase<Epi, FixedUnit, false, true>((PG8_LAS unsigned char*)lds, g, S, e);
}
__device__ __forceinline__ void phase_chain(const Params& p, int l, float* lds) {
    unsigned char* ws = p.ws;
    const int G = gridDim.x, bx = blockIdx.x, v = (bx % 8) * (G / 8) + bx / 8, pm = v >> 2, pn = v & 3;
    const float* xin = l == 0 ? p.x : p.out;
    const float* mod_l = (const float*)(ws + WS_MOD) + (size_t)l * 4 * 6144;
    bool same_l2;
    {
        volatile LAS unsigned* st = (volatile LAS unsigned*)((LAS unsigned char*)lds + LDS_MISC_OFF_C);
        if (threadIdx.x == 0) {
            unsigned* tab = (unsigned*)(ws + WS_CTL) + CTL_XCCTAB; const int v0 = v & ~3; unsigned ok = 1u, first = 0u;
#pragma unroll
            for (int j = 0; j < 4; ++j) { const int vj = v0 + j, bj = (vj % (G / 8)) * 8 + vj / (G / 8); const unsigned x = xb_ld(&tab[bj]); if (j == 0) first = x; ok &= (x == first && x != 0u) ? 1u : 0u; }
            st[3] = ok;
        }
        __syncthreads();
        same_l2 = __builtin_amdgcn_readfirstlane(st[3]) != 0u;
    }
    {
        XEpiGlu e{(const bf16_t*)(ws + WS_Z), (bf16_t*)(ws + WS_SO), p.b_glu + l * 512};
        for (int rep = 0; rep < 1 + (CHAIN_REP & 1); ++rep)
        run_unit(lds, (const bf16_t*)(ws + WS_Z), 512, (const bf16_t*)(ws + WS_WGLU) + (size_t)l * 512 * 512, 512, T, 512, 512, FixedUnit{pm, pn, pn < 2}, e);
        if (pn < 2) chain_signal(chain_ctr(p, l, 0, pm), same_l2);
        else if (BG_CONVERT) bg_convert(p, l, lds, BG_B3, BG_N3, pm * 2 + pn - 2, 128);
    }
    chain_wait(chain_ctr(p, l, 0, pm), 2u);
    {
        XEpiUpChain e{(const bf16_t*)(ws + WS_GS), (const bf16_t*)(ws + WS_GA), (bf16_t*)(ws + WS_MG)};
        pg8::Gemm g{(const bf16_t*)(ws + WS_SO), (const bf16_t*)(ws + WS_WSU) + (size_t)l * 1024 * 512, T, 1024, 512, 512, 512, 1 << 20, 0, (const bf16_t*)(ws + WS_AO), (const bf16_t*)(ws + WS_WAU) + (size_t)l * 1024 * 512, nullptr};
        pg8::gemm_phase<XEpiUpChain, FixedUnit2, false, true, true>((PG8_LAS unsigned char*)lds, g, FixedUnit2{pm, pn}, e);
        chain_signal(chain_ctr(p, l, 1, pm), same_l2);
    }
    chain_wait(chain_ctr(p, l, 1, pm), 4u);
    {
        if ((CHAIN_REP >> 2) & 1) { XEpiOut e0{xin, (float*)(ws + WS_YP), mod_l}; run_unit(lds, (const bf16_t*)(ws + WS_MG), 1024, (const bf16_t*)(ws + WS_WOUT) + (size_t)l * 1024 * 1024, 1024, T, 1024, 1024, FixedUnit{pm, pn, true}, e0); }
        XEpiOut e{xin, p.out, mod_l};
        run_unit(lds, (const bf16_t*)(ws + WS_MG), 1024, (const bf16_t*)(ws + WS_WOUT) + (size_t)l * 1024 * 1024, 1024, T, 1024, 1024, FixedUnit{pm, pn, true}, e);
        chain_signal(chain_ctr(p, l, 2, pm), same_l2);
    }
    chain_wait(chain_ctr(p, l, 2, pm), 4u);
    {
        const int w = opaque_tid() >> 6, row0 = pm * 256 + pn * 64;
        for (int rep = 0; rep < 1 + ((CHAIN_REP >> 3) & 1); ++rep)
        if (MOE_FP8) phase_norm2_rowsN<ROUTER_ROWS>(p, l, p.out, lds, row0 + w, NWAVES, row0 + 64);
        else phase_norm_rows<true>(p, l, p.out, lds, row0 + w, NWAVES, row0 + 64);
    }
}

enum { PH_NORM1 = 0, PH_INPROJ, PH_QKPOST, PH_ATTN, PH_SSM, PH_SSMPOST, PH_SSMMAIN, PH_GLU, PH_UP1, PH_UP2, PH_OUT, PH_NORM2, PH_TOPK, PH_GATHER, PH_MOE1, PH_MOE2, PH_COMBINE, PH_PER_LAYER, PH_PRO, PH_PRO2, PH_CHAIN };

template <int K>
__device__ __forceinline__ void run_phase(const Params& p, int l, float* lds) {
    unsigned char* ws = p.ws;
    const float* xin = l == 0 ? p.x : p.out;
    const float* mod_l = (const float*)(ws + WS_MOD) + (size_t)l * 4 * 6144;
    if constexpr (K == PH_NORM1) phase_norm<false>(p, l, xin, lds);
    else if constexpr (K == PH_INPROJ) {
#if FAST_INPROJ
        XEpiInProj e{(bf16_t*)(ws + WS_UX), (bf16_t*)(ws + WS_QB), (bf16_t*)(ws + WS_KB), (bf16_t*)(ws + WS_VB), (bf16_t*)(ws + WS_GS), (bf16_t*)(ws + WS_GA), (const float*)(ws + WS_ROPE), p.q_norm_w + l * 64, p.k_norm_w + l * 64, 0, 1.0f};
#if INPROJ_FP8
        run_gemm<XEpiInProj, true>(lds, (const bf16_t*)(ws + WS_H), 1024, (const bf16_t*)(ws + WS_WIN) + (size_t)l * NIN * 1024, 1024, T, 512, 1024, 1 << 20, 0, e);
        {
            XEpiInProj e8 = e; e8.pn_off = 2; e8.asc = 1.0f / FP8_WSCALE;
            pg8::Gemm g{(const bf16_t*)(ws + WS_H8A), (const bf16_t*)(ws + WS_WIN8 + (size_t)l * 2816 * 1024), T, 2816, 512, 512, 512, 1 << 20, 0, nullptr, nullptr, nullptr};
            InProjF8Order S; S.c = opaque_bid(); S.so.init(T, 2816, 256, S.c);
            pg8::gemm_phase<XEpiInProj, InProjF8Order, true, true, false, false, true>((PG8_LAS unsigned char*)lds, g, S, e8);
        }
#else
        run_gemm<XEpiInProj, true>(lds, (const bf16_t*)(ws + WS_H), 1024, (const bf16_t*)(ws + WS_WIN) + (size_t)l * NIN * 1024, 1024, T, NIN, 1024, 1 << 20, 0, e);
#endif
        if (BG_CONVERT && ONE_LAUNCH && blockIdx.x >= 192) { __syncthreads(); bg_convert(p, l, lds, BG_B1, BG_N1, blockIdx.x - 192, 64); }
#else
        EpiInProj e{(bf16_t*)(ws + WS_UX), (bf16_t*)(ws + WS_VB), (bf16_t*)(ws + WS_GS), (bf16_t*)(ws + WS_GA), (float*)(ws + WS_PQK)};
        gemm_naive((const bf16_t*)(ws + WS_H), 1024, 0, (const bf16_t*)(ws + WS_WIN) + (size_t)l * NIN * 1024, 1024, 0, T, NIN, 1024, 1, e, lds);
#endif
    }
    else if constexpr (K == PH_QKPOST) { if (!FAST_INPROJ) phase_qkpost(p, l); }
#if FAST_ATTN
    else if constexpr (K == PH_ATTN) {
#if FAST_SSM
        if (blockIdx.x < 64) {
            XEpiSloc e{(float*)(ws + WS_SLOC)};
            pg8::Gemm g{(const bf16_t*)(ws + WS_UX), (const bf16_t*)(ws + WS_SSMS) + (size_t)l * 32 * 256 * CU, 32 * RG, 256, CU, UXW, CU, RG / 256, (size_t)256 * CU, nullptr, nullptr, nullptr};
            OneUnitOrder S{64};
            pg8::gemm_phase<XEpiSloc, OneUnitOrder, false, true>((PG8_LAS unsigned char*)lds, g, S, e);
            asm volatile("s_waitcnt vmcnt(0)" ::: "memory"); __syncthreads();
            ssm_scan_unit(p, l, blockIdx.x);
            __syncthreads();
        } else if (BG_CONVERT && ONE_LAUNCH) { bg_convert(p, l, lds, BG_B5, BG_N5, blockIdx.x - 64, 192); __syncthreads(); }
#endif
{
            const int ln_ = opaque_tid() & 63;
            float mq = fabsf(p.q_norm_w[l * 64 + ln_]), mk = fabsf(p.k_norm_w[l * 64 + ln_]);
#pragma unroll
            for (int o_ = 32; o_ > 0; o_ >>= 1) { mq = fmaxf(mq, __int_as_float(__builtin_amdgcn_ds_bpermute((ln_ ^ o_) << 2, __float_as_int(mq)))); mk = fmaxf(mk, __int_as_float(__builtin_amdgcn_ds_bpermute((ln_ ^ o_) << 2, __float_as_int(mk)))); }
            const float sbound = fminf(QSCALE * 64.0f * mq * mk * 1.02f, 64.0f);
                    attn_body::attn_phase<-1>((char*)lds, (const attn_body::bf16*)(ws + WS_QB), (const attn_body::bf16*)(ws + WS_KB), (const attn_body::bf16*)(ws + WS_VB), (attn_body::bf16*)(ws + WS_AO), sbound);
        }
    }
#else
    else if constexpr (K == PH_ATTN) phase_attn_naive(p, lds);
#endif
#if FAST_SSM
    else if constexpr (K == PH_SSM) {
        XEpiSloc e{(float*)(ws + WS_SLOC)};
        run_gemm<XEpiSloc, false>(lds, (const bf16_t*)(ws + WS_UX), UXW, (const bf16_t*)(ws + WS_SSMS) + (size_t)l * 32 * 256 * CU, CU, 32 * RG, 256, CU, RG / 256, (size_t)256 * CU, e);
    }
    else if constexpr (K == PH_SSMPOST) phase_ssm_scan(p, l);
    else if constexpr (K == PH_SSMMAIN) {
        XEpiZ e{(bf16_t*)(ws + WS_Z)};
        run_gemm<XEpiZ, false>(lds, (const bf16_t*)(ws + WS_UX), UXW, (const bf16_t*)(ws + WS_SSMM) + (size_t)l * 32 * CU * UXW, UXW, 32 * RG, CU, UXW, RG / 256, (size_t)CU * UXW, e);
        if (BG_CONVERT && ONE_LAUNCH && blockIdx.x >= 128) bg_convert(p, l, lds, BG_B2, BG_N2, blockIdx.x - 128, 128);
    }
    else if constexpr (K == PH_PRO2) {
        if (blockIdx.x & 1) { phase_norm<false>(p, 0, p.x, lds); __syncthreads(); pro_ssm_expand(p, lds); }
        else { pro_ssm_expand(p, lds); __syncthreads(); phase_norm<false>(p, 0, p.x, lds); }
    }
#else
    else if constexpr (K == PH_SSM) phase_ssm_naive(p, l);
    else if constexpr (K == PH_SSMPOST) phase_ssmpost_naive(p, l);
    else if constexpr (K == PH_SSMMAIN) {}
    else if constexpr (K == PH_PRO2) phase_norm<false>(p, 0, p.x, lds);
#endif
    else if constexpr (K == PH_GLU) {
#if FAST_SMALLGEMM
        XEpiGlu e{(const bf16_t*)(ws + WS_Z), (bf16_t*)(ws + WS_SO), p.b_glu + l * 512};
        run_gemm<XEpiGlu, false>(lds, (const bf16_t*)(ws + WS_Z), 512, (const bf16_t*)(ws + WS_WGLU) + (size_t)l * 512 * 512, 512, T, 512, 512, 1 << 20, 0, e);
#else
        EpiGlu e{(const bf16_t*)(ws + WS_Z), (bf16_t*)(ws + WS_SO), p.b_glu + l * 512};
        gemm_naive((const bf16_t*)(ws + WS_Z), 512, 0, (const bf16_t*)(ws + WS_WGLU) + (size_t)l * 512 * 512, 512, 0, T, 512, 512, 1, e, lds);
#endif
    }
    else if constexpr (K == PH_UP1) {
#if FAST_SMALLGEMM
        XEpiUp<false> e{(const bf16_t*)(ws + WS_GS), (bf16_t*)(ws + WS_MG)};
        run_gemm<XEpiUp<false>, false>(lds, (const bf16_t*)(ws + WS_SO), 512, (const bf16_t*)(ws + WS_WSU) + (size_t)l * 1024 * 512, 512, T, 1024, 512, 1 << 20, 0, e);
#else
        EpiUp<false> e{(const bf16_t*)(ws + WS_GS), (bf16_t*)(ws + WS_MG)};
        gemm_naive((const bf16_t*)(ws + WS_SO), 512, 0, (const bf16_t*)(ws + WS_WSU) + (size_t)l * 1024 * 512, 512, 0, T, 1024, 512, 1, e, lds);
#endif
    }
    else if constexpr (K == PH_UP2) {
#if FAST_SMALLGEMM
        XEpiUp<true> e{(const bf16_t*)(ws + WS_GA), (bf16_t*)(ws + WS_MG)};
        run_gemm<XEpiUp<true>, false>(lds, (const bf16_t*)(ws + WS_AO), 512, (const bf16_t*)(ws + WS_WAU) + (size_t)l * 1024 * 512, 512, T, 1024, 512, 1 << 20, 0, e);
#else
        EpiUp<true> e{(const bf16_t*)(ws + WS_GA), (bf16_t*)(ws + WS_MG)};
        gemm_naive((const bf16_t*)(ws + WS_AO), 512, 0, (const bf16_t*)(ws + WS_WAU) + (size_t)l * 1024 * 512, 512, 0, T, 1024, 512, 1, e, lds);
#endif
    }
    else if constexpr (K == PH_OUT) {
#if FAST_SMALLGEMM
        XEpiOut e{xin, p.out, mod_l};
        run_gemm<XEpiOut, false>(lds, (const bf16_t*)(ws + WS_MG), 1024, (const bf16_t*)(ws + WS_WOUT) + (size_t)l * 1024 * 1024, 1024, T, 1024, 1024, 1 << 20, 0, e);
#else
        EpiOut e{xin, p.out, mod_l};
        gemm_naive((const bf16_t*)(ws + WS_MG), 1024, 0, (const bf16_t*)(ws + WS_WOUT) + (size_t)l * 1024 * 1024, 1024, 0, T, 1024, 1024, 1, e, lds);
#endif
    }
    else if constexpr (K == PH_NORM2) phase_norm<true>(p, l, p.out, lds);
    else if constexpr (K == PH_TOPK) { phase_topk(p, lds); if (BG_CONVERT && ONE_LAUNCH && blockIdx.x >= 64) bg_convert(p, l, lds, BG_B4, BG_N4, blockIdx.x - 64, 192); }
    else if constexpr (K == PH_GATHER) { if (!MOE_GATHER) phase_gather(p); }
    else if constexpr (K == PH_MOE1) {
        static_assert(FAST_MOE && MOE_GATHER, "the expert GEMMs are maintained only in their MFMA + gathered-A form");
#if MOE_FP8
        {
            XEpiMoe1F8 e{(unsigned char*)(ws + WS_HID)};
            pg8::Gemm g{(const bf16_t*)(ws + WS_H8), (const bf16_t*)(ws + WS_WGU + (size_t)l * 16 * 4096 * 1024), NE * 2048, 4096, 512, 512, 512, 8, (size_t)4096 * 512, nullptr, nullptr, (const int*)(ws + WS_SRC)};
            pg8::StaticOrder S; S.init(NE * 2048, 4096, (int)gridDim.x, (int)blockIdx.x);
            pg8::gemm_phase<XEpiMoe1F8, pg8::StaticOrder, true, true, false, true, true>((PG8_LAS unsigned char*)lds, g, S, e);
        }
#else
        {
            XEpiMoe1 e{(bf16_t*)(ws + WS_HID)};
            pg8::Gemm g{(const bf16_t*)(ws + WS_H), (const bf16_t*)(ws + WS_WGU) + (size_t)l * 16 * 4096 * 1024, NE * 2048, 4096, 1024, 1024, 1024, 8, (size_t)4096 * 1024, nullptr, nullptr, (const int*)(ws + WS_SRC)};
            pg8::StaticOrder S; S.init(NE * 2048, 4096, (int)gridDim.x, (int)blockIdx.x);
            pg8::gemm_phase<XEpiMoe1, pg8::StaticOrder, true, true, false, true>((PG8_LAS unsigned char*)lds, g, S, e);
        }
#endif
    }
    else if constexpr (K == PH_MOE2) {
#if MOE_FP8
        {
            XEpiMoe2 e{(bf16_t*)(ws + WS_YE), (const float*)(ws + WS_GATE), 1.0f / FP8_WSCALE};
            pg8::Gemm g{(const bf16_t*)(ws + WS_HID), (const bf16_t*)(ws + WS_WD + (size_t)l * 16 * 1024 * 2048), NE * 2048, 1024, 1024, 1024, 1024, 8, (size_t)1024 * 1024, nullptr, nullptr, nullptr};
            pg8::StaticOrder S; S.init(NE * 2048, 1024, (int)gridDim.x, (int)blockIdx.x);
            pg8::gemm_phase<XEpiMoe2, pg8::StaticOrder, true, true, false, false, true>((PG8_LAS unsigned char*)lds, g, S, e);
        }
#else
        XEpiMoe2 e{(bf16_t*)(ws + WS_YE), (const float*)(ws + WS_GATE), 1.0f};
        run_gemm<XEpiMoe2, true>(lds, (const bf16_t*)(ws + WS_HID), 2048, (const bf16_t*)(ws + WS_WD) + (size_t)l * 16 * 1024 * 2048, 2048, NE * 2048, 1024, 2048, 8, (size_t)1024 * 2048, e);
#endif
    }
    else if constexpr (K == PH_COMBINE) { if (COMBINE_PROBE) { phase_combine(p, l, (float*)(ws + WS_HID)); __syncthreads(); } phase_combine(p, l, p.out); }
    else if constexpr (K == PH_CHAIN) phase_chain(p, l, lds);
    else if constexpr (K == PH_PRO) {
        if (blockIdx.x & 1) { pro_weights(p, lds); __syncthreads(); pro_mod(p, lds); pro_rope(p); if (FAST_SSM) pro_ssm_gt(p, lds); }
        else { pro_mod(p, lds); pro_rope(p); if (FAST_SSM) pro_ssm_gt(p, lds); pro_weights(p, lds); }
    }
}

#if ONE_LAUNCH
constexpr int LDS_MISC_OFF = LDS_MISC_OFF_C;
constexpr int LDS_PARAMS_OFF = 131072 + 256;
constexpr int NPTR = sizeof(Params) / 8;
__device__ __forceinline__ Params params_from_lds(const LAS unsigned long long* lp) {
    unsigned a; asm volatile("v_mov_b32 %0, %1" : "=v"(a) : "s"((unsigned)(size_t)lp));
    const LAS unsigned long long* lq = (const LAS unsigned long long*)(size_t)a;
    unsigned long long tmp[NPTR];
#pragma unroll
    for (int i = 0; i < NPTR; ++i) {
        const unsigned long long v = lq[i];
        const unsigned lo = __builtin_amdgcn_readfirstlane((unsigned)v), hi = __builtin_amdgcn_readfirstlane((unsigned)(v >> 32));
        tmp[i] = ((unsigned long long)hi << 32) | lo;
    }
    typedef const __attribute__((address_space(1))) float* gcf_t;
    Params q;
    q.x = (const float*)(gcf_t)tmp[0]; q.c = (const float*)(gcf_t)tmp[1]; q.w_mod = (const float*)(gcf_t)tmp[2]; q.b_mod = (const float*)(gcf_t)tmp[3]; q.ln1_w = (const float*)(gcf_t)tmp[4];
    q.ln2_w = (const float*)(gcf_t)tmp[5]; q.w_in = (const float*)(gcf_t)tmp[6]; q.lam_re = (const float*)(gcf_t)tmp[7]; q.lam_im = (const float*)(gcf_t)tmp[8]; q.log_dt = (const float*)(gcf_t)tmp[9];
    q.b_re = (const float*)(gcf_t)tmp[10]; q.b_im = (const float*)(gcf_t)tmp[11]; q.c_re = (const float*)(gcf_t)tmp[12]; q.c_im = (const float*)(gcf_t)tmp[13]; q.ssm_d = (const float*)(gcf_t)tmp[14];
    q.w_glu = (const float*)(gcf_t)tmp[15]; q.b_glu = (const float*)(gcf_t)tmp[16]; q.q_norm_w = (const float*)(gcf_t)tmp[17]; q.k_norm_w = (const float*)(gcf_t)tmp[18]; q.w_ssm_up = (const float*)(gcf_t)tmp[19];
    q.w_attn_up = (const float*)(gcf_t)tmp[20]; q.w_out = (const float*)(gcf_t)tmp[21]; q.w_router = (const float*)(gcf_t)tmp[22]; q.w_eg = (const float*)(gcf_t)tmp[23]; q.w_eu = (const float*)(gcf_t)tmp[24];
    q.w_ed = (const float*)(gcf_t)tmp[25];
    q.out = (float*)(__attribute__((address_space(1))) float*)tmp[26]; q.ws = (unsigned char*)(__attribute__((address_space(1))) unsigned char*)tmp[27];
    static_assert(sizeof(Params) == 28 * 8, "Params = 28 pointers");
    return q;
}
__global__ void __launch_bounds__(NTHREADS, 2) mega(Params p0) {
    extern __shared__ __attribute__((aligned(16))) unsigned char lds_raw[];
    float* lds = (float*)lds_raw;
    cg::grid_group grid = cg::this_grid();
    volatile LAS unsigned* st = (volatile LAS unsigned*)((LAS unsigned char*)lds_raw + LDS_MISC_OFF);
    LAS unsigned long long* lp = (LAS unsigned long long*)((LAS unsigned char*)lds_raw + LDS_PARAMS_OFF);
    if (threadIdx.x == 0) {
        unsigned long long tmp[NPTR]; __builtin_memcpy(tmp, &p0, sizeof(p0));
#pragma unroll
        for (int i = 0; i < NPTR; ++i) lp[i] = tmp[i];
        st[0] = 0u; st[1] = 0u; st[2] = xb_xcc_id(); st[3] = 0u;
        (void)xb_add((unsigned*)(p0.ws + WS_CTL) + CTL_XCCTAB + blockIdx.x, xb_xcc_id() + 1u);
        (void)xb_add(&((unsigned*)(p0.ws + WS_CTL))[XB_XCNT(xb_xcc_id())], 1u);
    }
    __syncthreads();
#define BARRIER() do { const Params q_ = params_from_lds(lp); XcdBarrier b_; b_.bar = (unsigned*)(q_.ws + WS_CTL); b_.st = st; b_.x = 0; xcd_barrier(b_); } while (0)
#define RUN(K) do { const Params q_ = params_from_lds(lp); run_phase<K>(q_, l, lds); } while (0)
#ifndef DOUBLE_BARRIER
#define DOUBLE_BARRIER 0
#endif
#ifndef REPEAT_MASK
#define REPEAT_MASK 0
#endif
#define PHASE(K) do { RUN(K); if ((REPEAT_MASK >> (K)) & 1) { BARRIER(); RUN(K); } BARRIER(); if (DOUBLE_BARRIER) BARRIER(); } while (0)
    if (p0.ws == nullptr) grid.sync();
    { const int l = 0; RUN(PH_PRO); if ((REPEAT_MASK >> PH_PRO) & 1) { BARRIER(); RUN(PH_PRO); } BARRIER(); PHASE(PH_PRO2); }
#pragma unroll 1
    for (int l = 0; l < DEPTH; ++l) {
        PHASE(PH_INPROJ); PHASE(PH_ATTN); PHASE(PH_SSMMAIN); PHASE(PH_CHAIN);
        PHASE(PH_TOPK); if (!MOE_GATHER) PHASE(PH_GATHER); PHASE(PH_MOE1); PHASE(PH_MOE2);
        RUN(PH_COMBINE); if (l + 1 < DEPTH) BARRIER();
    }
#undef PHASE
#undef RUN
#undef BARRIER
}
#else
template <int K> __global__ void __launch_bounds__(NTHREADS, 2) phase_kernel(Params p, int l) {
    extern __shared__ __attribute__((aligned(16))) unsigned char lds_raw[];
    run_phase<K>(p, l, (float*)lds_raw);
}
template <int K> static bool setup_phase() { return hipFuncSetAttribute((const void*)phase_kernel<K>, hipFuncAttributeMaxDynamicSharedMemorySize, LDS_BYTES) == hipSuccess; }
template <int K> static void launch_phase(const Params& p, int l, int grid, hipStream_t stream) { hipLaunchKernelGGL(phase_kernel<K>, dim3(grid), dim3(NTHREADS), LDS_BYTES, stream, p, l); }
template <int... Ks> static bool setup_all(std::integer_sequence<int, Ks...>) { bool ok = true; ((ok = setup_phase<Ks>() && ok), ...); return ok; }
template <int... Ks> static void launch_layer(const Params& p, int l, int grid, hipStream_t stream, std::integer_sequence<int, Ks...>) { (launch_phase<Ks>(p, l, grid, stream), ...); }
#endif

extern "C" void kernel_launch(void* const* d_in, const int* in_sizes, int n_in, void* d_out, int out_size, void* d_ws, size_t ws_size, hipStream_t stream) {
    static int grid = 0;
    if (grid == 0) {
        if (n_in != 26 || out_size != T * D || ws_size < WS_END) { fprintf(stderr, "kernel_launch: unexpected shapes: n_in %d out %d ws %zu (need %zu)\n", n_in, out_size, ws_size, (size_t)WS_END); grid = -1; return; }
        int dev = 0, cus = 0, per_cu = 0;
        (void)hipGetDevice(&dev); (void)hipDeviceGetAttribute(&cus, hipDeviceAttributeMultiprocessorCount, dev);
#if ONE_LAUNCH
        if (hipFuncSetAttribute((const void*)mega, hipFuncAttributeMaxDynamicSharedMemorySize, LDS_BYTES) != hipSuccess) { fprintf(stderr, "kernel_launch: hipFuncSetAttribute failed\n"); grid = -1; return; }
        (void)hipOccupancyMaxActiveBlocksPerMultiprocessor(&per_cu, (const void*)mega, NTHREADS, LDS_BYTES);
        if (per_cu < 1) { fprintf(stderr, "kernel_launch: occupancy query says %d blocks/CU\n", per_cu); grid = -1; return; }
#else
        if (!setup_all(std::make_integer_sequence<int, PH_PRO2 + 1>{})) { fprintf(stderr, "kernel_launch: hipFuncSetAttribute failed\n"); grid = -1; return; }
        (void)per_cu;
#endif
        grid = cus;
        if (ONE_LAUNCH && grid != 256) { fprintf(stderr, "kernel_launch: the token-panel chain needs exactly 256 workgroups (one per CU of a 256-CU device); got %d CUs\n", cus); grid = -1; return; }
        (void)hipGetLastError();
    }
    if (grid < 0) return;
    Params p{};
    const float** pp = (const float**)&p;
    for (int i = 0; i < 26; ++i) pp[i] = (const float*)d_in[i];
    p.out = (float*)d_out; p.ws = (unsigned char*)d_ws;
#if ONE_LAUNCH
    (void)hipMemsetAsync((char*)d_ws + WS_CTL, 0, WS_ZERO + 2048, stream);
    void* args[] = {&p};
    hipError_t e = hipLaunchCooperativeKernel((const void*)mega, dim3(grid), dim3(NTHREADS), args, LDS_BYTES, stream);
    if (e != hipSuccess) fprintf(stderr, "cooperative launch failed: %s (grid %d)\n", hipGetErrorString(e), grid);
#else
    launch_phase<PH_PRO>(p, 0, grid, stream);
    launch_phase<PH_PRO2>(p, 0, grid, stream);
    for (int l = 0; l < DEPTH; ++l) launch_layer(p, l, grid, stream, std::make_integer_sequence<int, PH_PER_LAYER>{});
#endif
}
```

```cpp
#include <hip/hip_runtime.h>
#include <hip/hip_cooperative_groups.h>
#include <hip/hip_bf16.h>
#include <cstdio>
#include <cstdint>
#include <utility>
namespace cg = cooperative_groups;

#ifndef ONE_LAUNCH
#define ONE_LAUNCH 1
#endif
#ifndef FAST_MOE
#define FAST_MOE 1
#endif
#ifndef FAST_INPROJ
#define FAST_INPROJ 1
#endif
#ifndef MOE_FP8
#define MOE_FP8 1
#endif
#ifndef INPROJ_FP8
#define INPROJ_FP8 1
#endif
#ifndef MOE_GATHER
#define MOE_GATHER 1
#endif
#ifndef BG_CONVERT
#define BG_CONVERT 1
#endif
#ifndef CHAIN_REP
#define CHAIN_REP 0
#endif
#ifndef COMBINE_PROBE
#define COMBINE_PROBE 0
#ifndef YE_FP8
#define YE_FP8 1
#endif
constexpr float YE_SCALE = 64.0f;
#ifndef ROUTER_ROWS
#define ROUTER_ROWS 4
#endif
#endif
#ifndef FAST_ATTN
#define FAST_ATTN 1
#endif
#ifndef FAST_SSM
#define FAST_SSM 1
#endif
#ifndef FAST_SMALLGEMM
#define FAST_SMALLGEMM 1
#endif
static_assert(FAST_SSM && FAST_INPROJ, "the naive S5 / in-projection paths are not maintained for this workspace map");

typedef unsigned short bf16_t;
typedef unsigned v4u __attribute__((ext_vector_type(4)));
typedef unsigned v2u __attribute__((ext_vector_type(2)));
typedef float f32x4 __attribute__((ext_vector_type(4)));

constexpr int D = 1024, NB = 4, S = 4096, T = NB * S, DEPTH = 2;
constexpr int HD = 64, NQH = 8, NKVH = 2, DATT = 512, DKV = 128;
constexpr int DSSM = 512, NG = 32, NP = 64;
constexpr int NE = 16, CAP = 512, DFF = 2048;
constexpr int NIN = 3328;
constexpr int CL = 32, CLS = 5, NCH = S / CL;
constexpr int CU = CL * 16;
constexpr int UXW = CU + 256;
constexpr int RG = NB * NCH;
static_assert((1 << CLS) == CL && CL % 16 == 0 && UXW % 128 == 0 && CU % 128 == 0 && RG % 256 == 0, "S5 chunk geometry");
constexpr float EPS = 1e-6f;
constexpr float QSCALE = 0.125f * 1.4426950408889634f;
constexpr int NTHREADS = 512, NWAVES = 8;
constexpr int LDS_BYTES = 147456;

constexpr size_t MiB = 1u << 20;
constexpr size_t WS_CTL = 0;
constexpr size_t WS_ZERO = 512 * 1024;
constexpr size_t WS_MOD = 1 * MiB;
constexpr size_t WS_WIN = 2 * MiB;
constexpr size_t WS_WGLU = 15 * MiB;
constexpr size_t WS_WSU = 16 * MiB;
constexpr size_t WS_WAU = 18 * MiB;
constexpr size_t WS_WOUT = 20 * MiB;
constexpr size_t WS_WGU = 24 * MiB;
constexpr size_t WS_H8 = 152 * MiB;
constexpr size_t WS_H8A = 168 * MiB;
constexpr size_t WS_WIN8 = 184 * MiB;
constexpr size_t WS_WD = 280 * MiB;
constexpr size_t WS_SSMM = 408 * MiB;
constexpr size_t WS_SSMS = 568 * MiB;
constexpr size_t WS_SSMA = 600 * MiB;
constexpr size_t WS_ROPE = 601 * MiB;
constexpr size_t WS_AL = 601 * MiB + 65536;
constexpr size_t WS_GT = 640 * MiB;
constexpr size_t WS_H = 604 * MiB;
constexpr size_t WS_AFF = 636 * MiB;
constexpr size_t WS_IDX = 637 * MiB;
constexpr size_t WS_GATE = 637 * MiB + 128 * 1024;
constexpr size_t WS_INV = 637 * MiB + 256 * 1024;
constexpr size_t WS_SRC = 639 * MiB;
constexpr size_t WS_STG = 640 * MiB;
constexpr size_t WS_UX = WS_STG + 236 * MiB;
constexpr size_t WS_QB = WS_STG + 20 * MiB;
constexpr size_t WS_KB = WS_STG + 36 * MiB;
constexpr size_t WS_VB = WS_STG + 40 * MiB;
constexpr size_t WS_GS = WS_STG + 44 * MiB;
constexpr size_t WS_GA = WS_STG + 76 * MiB;
constexpr size_t WS_AO = WS_STG + 108 * MiB;
constexpr size_t WS_SLOC = WS_STG + 196 * MiB;
constexpr size_t WS_Z = WS_STG + 132 * MiB;
constexpr size_t WS_SO = WS_STG + 148 * MiB;
constexpr size_t WS_MG = WS_STG + 164 * MiB;
constexpr size_t WS_PQK = WS_STG + 196 * MiB;
constexpr size_t WS_YP = WS_STG + 236 * MiB;
constexpr size_t WS_XG = WS_STG;
constexpr size_t WS_HID = WS_STG + 64 * MiB;
constexpr size_t WS_YE = WS_STG + 192 * MiB;
constexpr size_t WS_END = WS_STG + 300 * MiB;

struct Params {
    const float *x, *c, *w_mod, *b_mod, *ln1_w, *ln2_w, *w_in, *lam_re, *lam_im, *log_dt, *b_re, *b_im, *c_re, *c_im, *ssm_d,
        *w_glu, *b_glu, *q_norm_w, *k_norm_w, *w_ssm_up, *w_attn_up, *w_out, *w_router, *w_eg, *w_eu, *w_ed;
    float* out;
    unsigned char* ws;
};

__device__ __forceinline__ int opaque_tid() { int t = threadIdx.x; asm volatile("" : "+v"(t)); return t; }
__device__ __forceinline__ int opaque_bid() { int b = blockIdx.x; asm volatile("" : "+s"(b)); return b; }
__device__ __forceinline__ float bf2f(bf16_t v) { return __uint_as_float(((unsigned)v) << 16); }
__device__ __forceinline__ unsigned f2bf(float f) { unsigned u = __float_as_uint(f); return (u + 0x7fffu + ((u >> 16) & 1u)) >> 16; }
typedef float f32x2_t __attribute__((ext_vector_type(2))); typedef __bf16 bf16x2_t __attribute__((ext_vector_type(2)));
__device__ __forceinline__ unsigned pk2(float lo, float hi) { f32x2_t v = {lo, hi}; bf16x2_t b = __builtin_convertvector(v, bf16x2_t); return __builtin_bit_cast(unsigned, b); }
constexpr float FP8_WSCALE = 32.0f;
__device__ __forceinline__ float clamp448(float v) { return __builtin_fminf(__builtin_fmaxf(v, -448.0f), 448.0f); }
__device__ __forceinline__ unsigned pk4_fp8(float a, float b, float c, float d) {
    int w = 0;
    w = __builtin_amdgcn_cvt_pk_fp8_f32(clamp448(a), clamp448(b), w, false);
    w = __builtin_amdgcn_cvt_pk_fp8_f32(clamp448(c), clamp448(d), w, true);
    return (unsigned)w;
}
__device__ __forceinline__ float lo16(unsigned w) { return __uint_as_float(w << 16); }
__device__ __forceinline__ float hi16(unsigned w) { return __uint_as_float(w & 0xffff0000u); }
__device__ __forceinline__ float wave_sum(float v, int lane) {
#pragma unroll
    for (int o = 32; o > 0; o >>= 1) v += __int_as_float(__builtin_amdgcn_ds_bpermute((lane ^ o) << 2, __float_as_int(v)));
    return v;
}
__device__ __forceinline__ float sigmoidf_(float v) { return __builtin_amdgcn_rcpf(1.0f + __builtin_amdgcn_exp2f(-1.4426950408889634f * v)); }
__device__ __forceinline__ float siluf_(float v) { return v * __builtin_amdgcn_rcpf(1.0f + __builtin_amdgcn_exp2f(-1.4426950408889634f * v)); }
__device__ __forceinline__ float gelu_tanh(float y) { const float u = 0.7978845608028654f * (y + 0.044715f * y * y * y); return 0.5f * y * (1.0f + tanhf(u)); }

__device__ __forceinline__ void pro_mod(const Params& p, float* lds) {
    const int tid = opaque_tid(), w = tid >> 6, lane = tid & 63;
    float* mod = (float*)(p.ws + WS_MOD);
    float* sc = lds + 2048;
    if (blockIdx.x < 192) {
        __syncthreads();
        for (int i = tid; i < 4096; i += NTHREADS) sc[i] = siluf_(p.c[i]);
        __syncthreads();
    }
    for (int it = blockIdx.x; it < 192; it += gridDim.x) {
        const int l = it / 96, n0 = (it % 96) * 64;
        const float* W = p.w_mod + (size_t)l * 1024 * 6144;
        float a0 = 0.f, a1 = 0.f, a2 = 0.f, a3 = 0.f;
        for (int kk = 0; kk < 128; kk += 64) {
            float wv[64];
#pragma unroll
            for (int u = 0; u < 64; ++u) wv[u] = __builtin_nontemporal_load(W + (size_t)(w * 128 + kk + u) * 6144 + n0 + lane);
#pragma unroll
            for (int u = 0; u < 64; ++u) {
                const int k = w * 128 + kk + u;
                a0 += sc[k] * wv[u]; a1 += sc[1024 + k] * wv[u]; a2 += sc[2048 + k] * wv[u]; a3 += sc[3072 + k] * wv[u];
            }
        }
        lds[(w * 4 + 0) * 64 + lane] = a0; lds[(w * 4 + 1) * 64 + lane] = a1; lds[(w * 4 + 2) * 64 + lane] = a2; lds[(w * 4 + 3) * 64 + lane] = a3;
        __syncthreads();
        if (tid < 256) {
            const int b = tid >> 6; float s = 0.f;
            for (int w2 = 0; w2 < 8; ++w2) s += lds[(w2 * 4 + b) * 64 + lane];
            mod[(size_t)(l * 4 + b) * 6144 + n0 + lane] = s + p.b_mod[l * 6144 + n0 + lane];
        }
        __syncthreads();
    }
}
__device__ __forceinline__ int inproj_row(int n) {
    if (n < 512) return n;
    if (n >= 1280) {
        const int c = n - 1280, isa = c >= 1024, cc = c & 1023;
        return 1280 + (cc >> 7) * 256 + isa * 128 + (cc & 127);
    }
    if (n < 1152) {
        const int hh = (n - 512) >> 6, d = n & 63, q4 = d >> 4, bj = q4 & 1, o = (q4 >> 1) * 16 + (d & 15);
        const int tile = hh < 8 ? 2 + (hh >> 2) : 4, wc = hh < 8 ? (hh & 3) : hh - 8;
        return tile * 256 + bj * 128 + wc * 32 + o;
    }
    const int vc = n - 1152, wc = 2 + (vc >> 6), dv = vc & 63;
    return 1024 + (dv >> 5) * 128 + wc * 32 + (dv & 31);
}
struct TItem { const float* W; bf16_t* WT; int K, N, k0, n0, drow0, mode, fp8; };
__device__ __forceinline__ void titem_load(const TItem& t, int lane, f32x4 (&v)[8]) {
#pragma unroll
    for (int i = 0; i < 8; ++i) v[i] = __builtin_nontemporal_load((const f32x4*)(t.W + (size_t)(t.k0 + i * 8 + (lane >> 3)) * t.N + t.n0 + (lane & 7) * 4));
}
__device__ __forceinline__ void titem_store(const TItem& t, int lane, const f32x4 (&v)[8], float* scr) {
#pragma unroll
    for (int i = 0; i < 8; ++i) { float* d = scr + (i * 8 + (lane >> 3)) * 33 + (lane & 7) * 4; d[0] = v[i].x; d[1] = v[i].y; d[2] = v[i].z; d[3] = v[i].w; }
    asm volatile("s_waitcnt lgkmcnt(0)" ::: "memory");
    const int c = lane & 7;
#pragma unroll
    for (int j = 0; j < 4; ++j) {
        const int n = (lane >> 3) + 8 * j; const float* s = scr + (8 * c) * 33 + n;
        const int drow = t.mode == 3 ? inproj_row(t.n0 + n) + t.drow0 : t.drow0 + n;
        if (t.fp8) {
            v2u o8; o8.x = pk4_fp8(s[0 * 33] * FP8_WSCALE, s[1 * 33] * FP8_WSCALE, s[2 * 33] * FP8_WSCALE, s[3 * 33] * FP8_WSCALE); o8.y = pk4_fp8(s[4 * 33] * FP8_WSCALE, s[5 * 33] * FP8_WSCALE, s[6 * 33] * FP8_WSCALE, s[7 * 33] * FP8_WSCALE);
            *(v2u*)((unsigned char*)t.WT + (size_t)drow * t.K + t.k0 + 8 * c) = o8;
        } else {
            v4u o; o.x = pk2(s[0 * 33], s[1 * 33]); o.y = pk2(s[2 * 33], s[3 * 33]); o.z = pk2(s[4 * 33], s[5 * 33]); o.w = pk2(s[6 * 33], s[7 * 33]);
            *(v4u*)(t.WT + (size_t)drow * t.K + t.k0 + 8 * c) = o;
        }
    }
    asm volatile("s_waitcnt lgkmcnt(0)" ::: "memory");
}
__device__ __forceinline__ void pro_rope(const Params& p) {
    float* rope = (float*)(p.ws + WS_ROPE);
    const int i = blockIdx.x * NTHREADS + opaque_tid();
    if (i < 1024) {
        const int pos = i >> 4, f = i & 15;
        const float inv = exp2f(-(float)f * (13.287712379549449f / 16.0f));
        float sn, cs; sincosf((float)pos * inv, &sn, &cs);
        rope[2 * i] = cs; rope[2 * i + 1] = sn;
    }
}
constexpr int EXP_ITEMS = 16 * 3072;
constexpr int BG_N1 = 3, BG_N2 = 10, BG_N3 = 7, BG_N4 = 4, BG_N5 = 14;
constexpr int BG_B1 = 0, BG_B2 = BG_B1 + 64 * 8 * BG_N1, BG_B3 = BG_B2 + 128 * 8 * BG_N2, BG_B4 = BG_B3 + 128 * 8 * BG_N3, BG_B5 = BG_B4 + 192 * 8 * BG_N4, BG_END = BG_B5 + 192 * 8 * BG_N5;
static_assert(BG_END <= EXP_ITEMS, "background conversion slots exceed the expert item count");
__device__ __forceinline__ TItem expert_item(const Params& p, int l, int idx) {
    const int e = idx / 3072, q = idx % 3072, which = q / 1024, r = q % 1024;
    const size_t le = (size_t)l * 16 + e;
    TItem t; t.mode = 0; t.fp8 = MOE_FP8;
    constexpr size_t ESZ = MOE_FP8 ? 1 : 2;
    if (which == 0) { t.W = p.w_eg + le * 1024 * 2048; t.K = 1024; t.N = 2048; t.WT = (bf16_t*)(p.ws + WS_WGU + le * 4096 * 1024 * ESZ); t.mode = 1; }
    else if (which == 1) { t.W = p.w_eu + le * 1024 * 2048; t.K = 1024; t.N = 2048; t.WT = (bf16_t*)(p.ws + WS_WGU + le * 4096 * 1024 * ESZ); t.mode = 2; }
    else { t.W = p.w_ed + le * 2048 * 1024; t.K = 2048; t.N = 1024; t.WT = (bf16_t*)(p.ws + WS_WD + le * 1024 * 2048 * ESZ); }
    const int nblk = t.N / 32, kb = r / nblk, nb = r % nblk; t.k0 = 64 * kb; t.n0 = 32 * nb;
    t.drow0 = t.n0;
    if (t.mode) t.drow0 = (t.n0 / 128) * 256 + (t.n0 % 128) + (t.mode == 2 ? 128 : 0);
    return t;
}
__device__ __forceinline__ void bg_convert(const Params& p, int l, float* lds, int base, int n, int rank, int nb) {
    const int tid = opaque_tid(), w = tid >> 6, lane = tid & 63;
    float* scr = lds + w * (64 * 33 + 16);
    const int first = base + rank * 8 + w, step = nb * 8;
    TItem ta = expert_item(p, l, first); f32x4 va[8]; titem_load(ta, lane, va);
    for (int k = 0; k < n; k += 2) {
        TItem tb = ta; f32x4 vb[8];
        if (k + 1 < n) { tb = expert_item(p, l, first + (k + 1) * step); titem_load(tb, lane, vb); }
        titem_store(ta, lane, va, scr);
        if (k + 1 < n) {
            if (k + 2 < n) { ta = expert_item(p, l, first + (k + 2) * step); titem_load(ta, lane, va); }
            titem_store(tb, lane, vb, scr);
        }
    }
}
__device__ __forceinline__ TItem pro_item(const Params& p, int it, int PER_L, int exp_base) {
    const int l = it / PER_L; int r = it % PER_L;
    if (r >= 2816) return expert_item(p, l, exp_base + r - 2816);
    TItem t; t.mode = 0; t.fp8 = 0;
    if (r < 1664) {
        t.W = p.w_in + (size_t)l * 1024 * NIN; t.K = 1024; t.N = NIN; t.WT = (bf16_t*)(p.ws + WS_WIN) + (size_t)l * NIN * 1024; t.mode = FAST_INPROJ ? 3 : 0;
        if (INPROJ_FP8 && (r % 104) * 32 >= 512) {
            t.k0 = 64 * (r / 104); t.n0 = 32 * (r % 104); t.drow0 = -512; t.fp8 = 1; t.WT = (bf16_t*)(p.ws + WS_WIN8 + (size_t)l * 2816 * 1024); return t;
        }
        if (FAST_INPROJ) { t.k0 = 64 * (r / 104); t.n0 = 32 * (r % 104); t.drow0 = 0; return t; }
    }
    else if (r < 1792) { r -= 1664; t.W = p.w_glu + (size_t)l * 512 * 512; t.K = 512; t.N = 512; t.WT = (bf16_t*)(p.ws + WS_WGLU) + (size_t)l * 512 * 512; }
    else if (r < 2048) { r -= 1792; t.W = p.w_ssm_up + (size_t)l * 512 * 1024; t.K = 512; t.N = 1024; t.WT = (bf16_t*)(p.ws + WS_WSU) + (size_t)l * 1024 * 512; }
    else if (r < 2304) { r -= 2048; t.W = p.w_attn_up + (size_t)l * 512 * 1024; t.K = 512; t.N = 1024; t.WT = (bf16_t*)(p.ws + WS_WAU) + (size_t)l * 1024 * 512; }
    else { r -= 2304; t.W = p.w_out + (size_t)l * 1024 * 1024; t.K = 1024; t.N = 1024; t.WT = (bf16_t*)(p.ws + WS_WOUT) + (size_t)l * 1024 * 1024; }
    const int nblk = t.N / 32, kb = r / nblk, nb = r % nblk; t.k0 = 64 * kb; t.n0 = 32 * nb; t.drow0 = t.n0;
    return t;
}
__device__ __forceinline__ void pro_weights(const Params& p, float* lds) {
    const int tid = opaque_tid(), w = tid >> 6, lane = tid & 63;
    float* scr = lds + w * (64 * 33 + 16);
    const int gw = blockIdx.x * NWAVES + w, NGW = gridDim.x * NWAVES;
    constexpr int EXPB = (BG_CONVERT && ONE_LAUNCH) ? BG_END : 0, PER_L = 2816 + EXP_ITEMS - EXPB, TOTAL = 2 * PER_L;
    if (gw >= TOTAL) return;
    TItem ta = pro_item(p, gw, PER_L, EXPB); f32x4 va[8]; titem_load(ta, lane, va);
    for (int it = gw; it < TOTAL; it += 2 * NGW) {
        TItem tb = ta; f32x4 vb[8]; const bool hb = it + NGW < TOTAL;
        if (hb) { tb = pro_item(p, it + NGW, PER_L, EXPB); titem_load(tb, lane, vb); }
        titem_store(ta, lane, va, scr);
        if (hb) {
            if (it + 2 * NGW < TOTAL) { ta = pro_item(p, it + 2 * NGW, PER_L, EXPB); titem_load(ta, lane, va); }
            titem_store(tb, lane, vb, scr);
        }
    }
}

template <bool ROUTER>
__device__ __forceinline__ void phase_norm_rows(const Params& p, int l, const float* xin, float* lds, int gw, int NGW, int mend) {
    const int tid = opaque_tid(), lane = tid & 63;
    const float* lnw = (ROUTER ? p.ln2_w : p.ln1_w) + l * 1024;
    const float* mod = (const float*)(p.ws + WS_MOD);
    bf16_t* H = (bf16_t*)(p.ws + WS_H);
    float* AFF = (float*)(p.ws + WS_AFF);
    if (ROUTER) {
        const float* wr = p.w_router + (size_t)l * 1024 * 16;
        __syncthreads();
        for (int i = tid; i < 4096; i += NTHREADS) { const f32x4 v = *(const f32x4*)(wr + (size_t)i * 4); const int k = i >> 2, e4 = (i & 3) * 4; lds[(e4 + 0) * 1024 + k] = v.x; lds[(e4 + 1) * 1024 + k] = v.y; lds[(e4 + 2) * 1024 + k] = v.z; lds[(e4 + 3) * 1024 + k] = v.w; }
        __syncthreads();
    }
    f32x4 vn[4];
    if (gw < mend) {
#pragma unroll
        for (int j = 0; j < 4; ++j) vn[j] = *(const f32x4*)(xin + (size_t)gw * 1024 + j * 256 + lane * 4);
    }
    for (int m = gw; m < mend; m += NGW) {
        const int b = m >> 12;
        const float* modb = mod + (size_t)(l * 4 + b) * 6144 + (ROUTER ? 3072 : 0);
        f32x4 v[4]; float ss = 0.f;
#pragma unroll
        for (int j = 0; j < 4; ++j) { v[j] = vn[j]; ss += v[j].x * v[j].x + v[j].y * v[j].y + v[j].z * v[j].z + v[j].w * v[j].w; }
        if (m + NGW < mend) {
#pragma unroll
            for (int j = 0; j < 4; ++j) vn[j] = *(const f32x4*)(xin + (size_t)(m + NGW) * 1024 + j * 256 + lane * 4);
        }
        const float r = rsqrtf(wave_sum(ss, lane) * (1.0f / 1024.0f) + EPS);
        float lg[16];
        if (ROUTER) {
#pragma unroll
            for (int e = 0; e < 16; ++e) lg[e] = 0.f;
        }
#pragma unroll
        for (int j = 0; j < 4; ++j) {
            const int col = j * 256 + lane * 4;
            const f32x4 w4 = *(const f32x4*)(lnw + col), sh = *(const f32x4*)(modb + col), sc = *(const f32x4*)(modb + 1024 + col);
            f32x4 h;
            h.x = v[j].x * r * w4.x * (1.f + sc.x) + sh.x; h.y = v[j].y * r * w4.y * (1.f + sc.y) + sh.y;
            h.z = v[j].z * r * w4.z * (1.f + sc.z) + sh.z; h.w = v[j].w * r * w4.w * (1.f + sc.w) + sh.w;
            if (ROUTER && MOE_FP8) *(unsigned*)((unsigned char*)(p.ws + WS_H8) + (size_t)m * 1024 + col) = pk4_fp8(h.x, h.y, h.z, h.w);
            else {
                v2u o; o.x = pk2(h.x, h.y); o.y = pk2(h.z, h.w); *(v2u*)(H + (size_t)m * 1024 + col) = o;
                if (INPROJ_FP8 && !ROUTER) *(unsigned*)((unsigned char*)(p.ws + WS_H8A) + (size_t)m * 1024 + col) = pk4_fp8(h.x, h.y, h.z, h.w);
            }
            if (ROUTER) {
#pragma unroll
                for (int e = 0; e < 16; ++e) { const f32x4 ww = *(const f32x4*)(lds + e * 1024 + col); lg[e] += h.x * ww.x + h.y * ww.y + h.z * ww.z + h.w * ww.w; }
            }
        }
        if (ROUTER) {
#define XCH(x, msk) __int_as_float(__builtin_amdgcn_ds_bpermute((lane ^ (msk)) << 2, __float_as_int(x)))
            float r8[8], r4[4], r2[2], r1;
            { const bool hi = lane & 32;
#pragma unroll
              for (int i = 0; i < 8; ++i) { const float keep = hi ? lg[8 + i] : lg[i], send = hi ? lg[i] : lg[8 + i]; r8[i] = keep + XCH(send, 32); } }
            { const bool hi = lane & 16;
#pragma unroll
              for (int i = 0; i < 4; ++i) { const float keep = hi ? r8[4 + i] : r8[i], send = hi ? r8[i] : r8[4 + i]; r4[i] = keep + XCH(send, 16); } }
            { const bool hi = lane & 8;
#pragma unroll
              for (int i = 0; i < 2; ++i) { const float keep = hi ? r4[2 + i] : r4[i], send = hi ? r4[i] : r4[2 + i]; r2[i] = keep + XCH(send, 8); } }
            { const bool hi = lane & 4; const float keep = hi ? r2[1] : r2[0], send = hi ? r2[0] : r2[1]; r1 = keep + XCH(send, 4); }
            r1 += XCH(r1, 2); r1 += XCH(r1, 1);
            float mx = r1;
            mx = fmaxf(mx, XCH(mx, 4)); mx = fmaxf(mx, XCH(mx, 8)); mx = fmaxf(mx, XCH(mx, 16)); mx = fmaxf(mx, XCH(mx, 32));
            const float ex = expf(r1 - mx);
            float sum = ex;
            sum += XCH(sum, 4); sum += XCH(sum, 8); sum += XCH(sum, 16); sum += XCH(sum, 32);
#undef XCH
            if ((lane & 3) == 0) AFF[(size_t)(b * 16 + (lane >> 2)) * 4096 + (m & 4095)] = ex / sum;
        }
    }
}
template <int NR>
__device__ __forceinline__ void phase_norm2_rowsN(const Params& p, int l, const float* xin, float* lds, int gw, int NGW, int mend) {
    const int tid = opaque_tid(), lane = tid & 63;
    const float* lnw = p.ln2_w + l * 1024;
    const float* mod = (const float*)(p.ws + WS_MOD);
    float* AFF = (float*)(p.ws + WS_AFF);
    {
        const float* wr = p.w_router + (size_t)l * 1024 * 16;
        __syncthreads();
        for (int i = tid; i < 4096; i += NTHREADS) { const f32x4 v = *(const f32x4*)(wr + (size_t)i * 4); const int k = i >> 2, e4 = (i & 3) * 4; lds[(e4 + 0) * 1024 + k] = v.x; lds[(e4 + 1) * 1024 + k] = v.y; lds[(e4 + 2) * 1024 + k] = v.z; lds[(e4 + 3) * 1024 + k] = v.w; }
        __syncthreads();
    }
    for (int m = gw; m < mend; m += NR * NGW) {
        const int b = m >> 12;
        const float* modb = mod + (size_t)(l * 4 + b) * 6144 + 3072;
        float rs[NR];
        {
#pragma unroll
            for (int q = 0; q < NR; ++q) {
                f32x4 v[4]; float ss = 0.f;
#pragma unroll
                for (int j = 0; j < 4; ++j) v[j] = *(const f32x4*)(xin + (size_t)(m + q * NGW) * 1024 + j * 256 + lane * 4);
#pragma unroll
                for (int j = 0; j < 4; ++j) ss += v[j].x * v[j].x + v[j].y * v[j].y + v[j].z * v[j].z + v[j].w * v[j].w;
                rs[q] = ss;
            }
#pragma unroll
            for (int q = 0; q < NR; ++q) rs[q] = rsqrtf(wave_sum(rs[q], lane) * (1.0f / 1024.0f) + EPS);
        }
        float lg[NR][16];
#pragma unroll
        for (int q = 0; q < NR; ++q)
#pragma unroll
            for (int e = 0; e < 16; ++e) lg[q][e] = 0.f;
        f32x4 cx[NR], cw, csh, csc;
#pragma unroll
        for (int q = 0; q < NR; ++q) cx[q] = *(const f32x4*)(xin + (size_t)(m + q * NGW) * 1024 + lane * 4);
        cw = *(const f32x4*)(lnw + lane * 4); csh = *(const f32x4*)(modb + lane * 4); csc = *(const f32x4*)(modb + 1024 + lane * 4);
#pragma unroll 1
        for (int j = 0; j < 4; ++j) {
            const int col = j * 256 + lane * 4, coln = (j < 3 ? j + 1 : j) * 256 + lane * 4;
            f32x4 nx[NR], nw, nsh, nsc;
#pragma unroll
            for (int q = 0; q < NR; ++q) nx[q] = *(const f32x4*)(xin + (size_t)(m + q * NGW) * 1024 + coln);
            nw = *(const f32x4*)(lnw + coln); nsh = *(const f32x4*)(modb + coln); nsc = *(const f32x4*)(modb + 1024 + coln);
            const f32x4 w4 = cw, sh = csh, sc = csc;
            f32x4 h[NR];
#pragma unroll
            for (int q = 0; q < NR; ++q) {
                const f32x4 x = cx[q]; const float r = rs[q];
                h[q].x = x.x * r * w4.x * (1.f + sc.x) + sh.x; h[q].y = x.y * r * w4.y * (1.f + sc.y) + sh.y; h[q].z = x.z * r * w4.z * (1.f + sc.z) + sh.z; h[q].w = x.w * r * w4.w * (1.f + sc.w) + sh.w;
                *(unsigned*)((unsigned char*)(p.ws + WS_H8) + (size_t)(m + q * NGW) * 1024 + col) = pk4_fp8(h[q].x, h[q].y, h[q].z, h[q].w);
            }
#pragma unroll
            for (int e = 0; e < 16; ++e) {
                const f32x4 ww = *(const f32x4*)(lds + e * 1024 + col);
#pragma unroll
                for (int q = 0; q < NR; ++q) lg[q][e] += h[q].x * ww.x + h[q].y * ww.y + h[q].z * ww.z + h[q].w * ww.w;
            }
#pragma unroll
            for (int q = 0; q < NR; ++q) cx[q] = nx[q];
            cw = nw; csh = nsh; csc = nsc;
        }
#define XCH(x, msk) __int_as_float(__builtin_amdgcn_ds_bpermute((lane ^ (msk)) << 2, __float_as_int(x)))
#pragma unroll
        for (int q = 0; q < NR; ++q) {
            float r8[8], r4[4], r2[2], r1;
            { const bool hi = lane & 32;
#pragma unroll
              for (int i = 0; i < 8; ++i) { const float keep = hi ? lg[q][8 + i] : lg[q][i], send = hi ? lg[q][i] : lg[q][8 + i]; r8[i] = keep + XCH(send, 32); } }
            { const bool hi = lane & 16;
#pragma unroll
              for (int i = 0; i < 4; ++i) { const float keep = hi ? r8[4 + i] : r8[i], send = hi ? r8[i] : r8[4 + i]; r4[i] = keep + XCH(send, 16); } }
            { const bool hi = lane & 8;
#pragma unroll
              for (int i = 0; i < 2; ++i) { const float keep = hi ? r4[2 + i] : r4[i], send = hi ? r4[i] : r4[2 + i]; r2[i] = keep + XCH(send, 8); } }
            { const bool hi = lane & 4; const float keep = hi ? r2[1] : r2[0], send = hi ? r2[0] : r2[1]; r1 = keep + XCH(send, 4); }
            r1 += XCH(r1, 2); r1 += XCH(r1, 1);
            float mx = r1;
            mx = fmaxf(mx, XCH(mx, 4)); mx = fmaxf(mx, XCH(mx, 8)); mx = fmaxf(mx, XCH(mx, 16)); mx = fmaxf(mx, XCH(mx, 32));
            const float ex = expf(r1 - mx);
            float sum = ex;
            sum += XCH(sum, 4); sum += XCH(sum, 8); sum += XCH(sum, 16); sum += XCH(sum, 32);
            if ((lane & 3) == 0) AFF[(size_t)(b * 16 + (lane >> 2)) * 4096 + ((m + q * NGW) & 4095)] = ex / sum;
        }
#undef XCH
    }
}
template <bool ROUTER>
__device__ __forceinline__ void phase_norm(const Params& p, int l, const float* xin, float* lds) {
    const int w = opaque_tid() >> 6;
    phase_norm_rows<ROUTER>(p, l, xin, lds, blockIdx.x * NWAVES + w, gridDim.x * NWAVES, T);
}

template <class Epi>
__device__ __forceinline__ void gemm_naive(const bf16_t* A, int lda, size_t strideA, const bf16_t* Bt, int ldb, size_t strideB, int M, int N, int K, int ngroups, const Epi& epi, float* lds) {
    const int tid = opaque_tid(), ty = tid >> 4, tx = tid & 15;
    float* As = lds;
    float* Bs = lds + 16 * 132;
    const int ntm = M / 128, ntn = N / 256, per_g = ntm * ntn, total = ngroups * per_g;
    for (int tile = blockIdx.x; tile < total; tile += gridDim.x) {
        const int g = tile / per_g, r = tile % per_g, m0 = (r / ntn) * 128, n0 = (r % ntn) * 256;
        const bf16_t* Ag = A + (size_t)g * strideA; const bf16_t* Bg = Bt + (size_t)g * strideB;
        float acc[4][16];
#pragma unroll
        for (int i = 0; i < 4; ++i)
#pragma unroll
            for (int j = 0; j < 16; ++j) acc[i][j] = 0.f;
        for (int k0 = 0; k0 < K; k0 += 16) {
            __syncthreads();
            {
                const int row = tid >> 2, k4 = (tid & 3) * 4;
                const v2u a = *(const v2u*)(Ag + (size_t)(m0 + row) * lda + k0 + k4);
                As[(k4 + 0) * 132 + row] = lo16(a.x); As[(k4 + 1) * 132 + row] = hi16(a.x); As[(k4 + 2) * 132 + row] = lo16(a.y); As[(k4 + 3) * 132 + row] = hi16(a.y);
                const int brow = tid >> 1, k8 = (tid & 1) * 8;
                const v4u b = *(const v4u*)(Bg + (size_t)(n0 + brow) * ldb + k0 + k8);
                Bs[(k8 + 0) * 260 + brow] = lo16(b.x); Bs[(k8 + 1) * 260 + brow] = hi16(b.x); Bs[(k8 + 2) * 260 + brow] = lo16(b.y); Bs[(k8 + 3) * 260 + brow] = hi16(b.y);
                Bs[(k8 + 4) * 260 + brow] = lo16(b.z); Bs[(k8 + 5) * 260 + brow] = hi16(b.z); Bs[(k8 + 6) * 260 + brow] = lo16(b.w); Bs[(k8 + 7) * 260 + brow] = hi16(b.w);
            }
            __syncthreads();
#pragma unroll 2
            for (int k = 0; k < 16; ++k) {
                const f32x4 a = *(const f32x4*)(As + k * 132 + ty * 4);
                const f32x4 b0 = *(const f32x4*)(Bs + k * 260 + tx * 8), b1 = *(const f32x4*)(Bs + k * 260 + tx * 8 + 4);
                const f32x4 b2 = *(const f32x4*)(Bs + k * 260 + 128 + tx * 8), b3 = *(const f32x4*)(Bs + k * 260 + 128 + tx * 8 + 4);
                const float av[4] = {a.x, a.y, a.z, a.w};
                const float bv[16] = {b0.x, b0.y, b0.z, b0.w, b1.x, b1.y, b1.z, b1.w, b2.x, b2.y, b2.z, b2.w, b3.x, b3.y, b3.z, b3.w};
#pragma unroll
                for (int i = 0; i < 4; ++i)
#pragma unroll
                    for (int j = 0; j < 16; ++j) acc[i][j] += av[i] * bv[j];
            }
        }
#pragma unroll
        for (int i = 0; i < 4; ++i)
#pragma unroll
            for (int j = 0; j < 8; ++j) epi(g, m0 + ty * 4 + i, n0, tx * 8 + j, acc[i][j], acc[i][8 + j]);
    }
}


namespace pg8 {
#define PG8_LAS __attribute__((address_space(3)))
typedef short bf16x8 __attribute__((ext_vector_type(8)));
typedef unsigned u32x4 __attribute__((ext_vector_type(4)));
constexpr int BM = 256, BK = 64, HALF = 128, HTB = HALF * BK * 2  , STAGE_BYTES = 8 * HTB, NXCD = 8, WGM = 8;
__host__ __device__ __forceinline__ int lds_byte(int r, int c) { const int st = (r >> 4) * 2 + (c >> 5), rr = r & 15, cc = c & 31, ob = rr * 64 + cc * 2; return st * 1024 + (ob ^ (((ob >> 9) & 1) << 5)); }
__host__ __device__ __forceinline__ void stage_rc(int b, int& R, int& C) { const int st = b / 1024, sb = b % 1024, swz = sb ^ (((sb >> 9) & 1) << 5); R = (st >> 1) * 16 + swz / 64; C = (st & 1) * 32 + (swz % 64) / 2; }
__host__ __device__ __forceinline__ int perm32(int rho) { const int n = rho >> 4, i = rho & 15; return 8 * (i >> 2) + 4 * n + (i & 3); }
typedef int v4i_t __attribute__((ext_vector_type(4))); typedef int v8i_t __attribute__((ext_vector_type(8)));
__device__ __forceinline__ v8i_t cat8(bf16x8 lo, bf16x8 hi) { const v4i_t a = __builtin_bit_cast(v4i_t, lo), b = __builtin_bit_cast(v4i_t, hi); return __builtin_shufflevector(a, b, 0, 1, 2, 3, 4, 5, 6, 7); }
__device__ __forceinline__ void mfma_fp8_acc(f32x4& acc, v8i_t a, v8i_t b, int scale) {
    asm volatile("s_nop 1\n\tv_mfma_scale_f32_16x16x128_f8f6f4 %0, %1, %2, %0, %3, %3 op_sel_hi:[0,0,0]" : "+v"(acc) : "v"(a), "v"(b), "v"(scale));
}
struct Unit { int pm, pn; };
struct Gemm { const bf16_t* A; const bf16_t* Bt; int M, N, K, lda, ldb, mt_per_group; size_t strideB; const bf16_t* A2; const bf16_t* Bt2; const int* rowsrc; };
struct StaticOrder {
    int nM, nN, nwg, G, c;
    __host__ __device__ void init(int M, int N, int G_, int c_) { nM = M / BM; nN = N / BM; nwg = nM * nN; G = G_; c = c_; }
    __host__ __device__ bool next(int i, Unit& u) const { return at((long)i * G + c, u); }
    __host__ __device__ bool at(long L, Unit& u) const {
        if (L < 0 || L >= nwg) return false;
        int wgid = (int)L; { const int q = nwg / NXCD, r = nwg % NXCD, xcd = wgid % NXCD, off = wgid / NXCD; wgid = (xcd < r ? xcd * (q + 1) : r * (q + 1) + (xcd - r) * q) + off; }
        const int nig = WGM * nN, gid = wgid / nig, fm = gid * WGM, gsz = (nM - fm) < WGM ? (nM - fm) : WGM;
        u.pm = fm + ((wgid % nig) % gsz); u.pn = (wgid % nig) / gsz; return true;
    }
    __device__ __forceinline__ void a_ready(const Unit&) const {}
    __device__ __forceinline__ void done(const Unit&) const {}
};
template <class Epi, class Sched, bool ALIGN_EPI = false, bool SP2 = false, bool CHAIN2 = false, bool GATHER = false, bool FP8 = false>
__device__ __forceinline__ void gemm_phase(PG8_LAS unsigned char* lds, const Gemm g, const Sched& S, const Epi& E) {
    const int tid = opaque_tid(), wid = __builtin_amdgcn_readfirstlane(tid >> 6), lane = tid & 63, wr = wid >> 2, wc = wid & 3, fr = lane & 15, fq = lane >> 4;
    const int K = g.K, nt = K / BK;
    int fp8_unit_scale = 0x7f7f7f7f; asm volatile("" : "+v"(fp8_unit_scale));
    unsigned voffA[2], voffB[2];
    unsigned cG0[2], cG1[2], sG0[2], sG1[2]; int gR[2], gC[2];
#pragma unroll
    for (int i = 0; i < 2; ++i) { int R, C; stage_rc(tid * 16 + i * 8192, R, C); const int Rb = Epi::PERM ? ((R & ~31) + perm32(R & 31)) : R;
        voffA[i] = (unsigned)(R * g.lda + C) * 2u; voffB[i] = (unsigned)(Rb * g.ldb + C) * 2u; gR[i] = R; gC[i] = C; }
    const size_t kstep = (size_t)(BK * 2);
    const size_t hstepA = GATHER ? 0 : (size_t)HALF * g.lda * 2, hstepB = (size_t)HALF * g.ldb * 2;
    const size_t tstepA = 2 * hstepA, tstepB = 2 * hstepB;
    const size_t gstepB = g.strideB * 2;
    const unsigned ldsw = (unsigned)wid * 1024u;
    const int aoff = lds_byte(wr * 64 + fr, fq * 8), boff = lds_byte(wc * 32 + fr, fq * 8);
#define PG8_VC0 (GATHER ? cG0 : voffA)
#define PG8_VC1 (GATHER ? cG1 : voffA)
#define PG8_VS0 (GATHER ? sG0 : voffA)
#define PG8_VS1 (GATHER ? sG1 : voffA)
#define PG8_GOFF(dst0, dst1, pm_) do { _Pragma("unroll") for (int _i = 0; _i < 2; ++_i) { \
        dst0[_i] = (unsigned)(g.rowsrc[(pm_) * BM + gR[_i]] * g.lda + gC[_i]) * 2u; dst1[_i] = (unsigned)(g.rowsrc[(pm_) * BM + HALF + gR[_i]] * g.lda + gC[_i]) * 2u; } } while (0)
#define PG8_SA(b, h) (((b) * 2 + (h)) * HTB)
#define PG8_SB(b, h) ((4 + (b) * 2 + (h)) * HTB)
#define PG8_STAGE(bufoff, gbase, voff) do { _Pragma("unroll") for (int _i = 0; _i < 2; ++_i) \
        __builtin_amdgcn_global_load_lds((const unsigned*)((const char*)(gbase) + (voff)[_i]), (PG8_LAS unsigned*)(lds + (bufoff) + ldsw + _i * 8192), 16, 0, 0); } while (0)
#define PG8_LDA(dst, b, h) do { _Pragma("unroll") for (int m = 0; m < 4; ++m) _Pragma("unroll") for (int k = 0; k < 2; ++k) dst[m][k] = *(const PG8_LAS bf16x8*)(lds + PG8_SA(b, h) + aoff + m * 2048 + k * 1024); } while (0)
#define PG8_LDB(dst, b, h) do { _Pragma("unroll") for (int n = 0; n < 2; ++n) _Pragma("unroll") for (int k = 0; k < 2; ++k) dst[n][k] = *(const PG8_LAS bf16x8*)(lds + PG8_SB(b, h) + boff + n * 2048 + k * 1024); } while (0)
#define PG8_MMA(ai, bj, At, Bt) do { __builtin_amdgcn_s_setprio(1); _Pragma("unroll") for (int m = 0; m < 4; ++m) _Pragma("unroll") for (int n = 0; n < 2; ++n) { \
        if constexpr (FP8) mfma_fp8_acc(acc[ai][bj][m][n], cat8(Bt[n][0], Bt[n][1]), cat8(At[m][0], At[m][1]), fp8_unit_scale); \
        else { _Pragma("unroll") for (int k = 0; k < 2; ++k) acc[ai][bj][m][n] = __builtin_amdgcn_mfma_f32_16x16x32_bf16(Bt[n][k], At[m][k], acc[ai][bj][m][n], 0, 0, 0); } } \
        __builtin_amdgcn_s_setprio(0); } while (0)
#define PG8_WAIT_V(n) asm volatile("s_waitcnt vmcnt(" #n ")" ::: "memory")
#define PG8_WAIT_L(n) asm volatile("s_waitcnt lgkmcnt(" #n ")" ::: "memory")
#define PG8_BAR __builtin_amdgcn_s_barrier()
#define PG8_SCHED __builtin_amdgcn_sched_barrier(0)
    Unit cur, nxt; int ui = 0;
    if (!S.next(0, cur)) return;
    f32x4 acc[2][2][4][2];
#pragma unroll
    for (int a = 0; a < 2; ++a)
#pragma unroll
        for (int b = 0; b < 2; ++b)
#pragma unroll
            for (int m = 0; m < 4; ++m)
#pragma unroll
                for (int n = 0; n < 2; ++n) acc[a][b][m][n] = (f32x4){0.f, 0.f, 0.f, 0.f};
    bf16x8 At[4][2], B0[2][2], B1[2][2];
    const char* cA = (const char*)g.A + (size_t)cur.pm * tstepA; const char* cB = (const char*)g.Bt + (size_t)(cur.pm / g.mt_per_group) * gstepB + (size_t)cur.pn * tstepB;
    if constexpr (GATHER) { PG8_GOFF(cG0, cG1, cur.pm); }
    S.a_ready(cur);
    if constexpr (SP2) {
        PG8_STAGE(PG8_SB(0, 0), cB, voffB); PG8_STAGE(PG8_SB(0, 1), cB + hstepB, voffB); PG8_STAGE(PG8_SA(0, 0), cA, PG8_VC0); PG8_STAGE(PG8_SA(0, 1), cA + hstepA, PG8_VC1);
        if (wr == 1) PG8_BAR;
        PG8_WAIT_V(2); PG8_BAR;
        PG8_STAGE(PG8_SB(1, 0), cB + kstep, voffB); PG8_STAGE(PG8_SA(1, 0), cA + kstep, PG8_VC0); PG8_STAGE(PG8_SB(1, 1), cB + hstepB + kstep, voffB);
        PG8_WAIT_V(6); PG8_BAR;
    } else {
        PG8_STAGE(PG8_SB(0, 0), cB, voffB); PG8_STAGE(PG8_SA(0, 0), cA, voffA); PG8_STAGE(PG8_SB(0, 1), cB + hstepB, voffB); PG8_STAGE(PG8_SA(0, 1), cA + hstepA, voffA);
        if (wr == 1) PG8_BAR;
        PG8_WAIT_V(4); PG8_BAR;
        PG8_STAGE(PG8_SB(1, 0), cB + kstep, voffB); PG8_STAGE(PG8_SA(1, 0), cA + kstep, voffA); PG8_STAGE(PG8_SB(1, 1), cB + hstepB + kstep, voffB);
        PG8_WAIT_V(6); PG8_BAR;
    }
    for (;;) {
        const bool has_next = S.next(ui + 1, nxt);
        unsigned nG0[2], nG1[2];
        if constexpr (GATHER) { if (has_next) { PG8_GOFF(nG0, nG1, nxt.pm); } else { nG0[0] = cG0[0]; nG0[1] = cG0[1]; nG1[0] = cG1[0]; nG1[1] = cG1[1]; } }
        const bf16_t* nbA = (CHAIN2 && !(ui & 1)) ? g.A2 : g.A; const bf16_t* nbB = (CHAIN2 && !(ui & 1)) ? g.Bt2 : g.Bt;
        const char* nA = has_next ? (const char*)nbA + (size_t)nxt.pm * tstepA : cA; const char* nB = has_next ? (const char*)nbB + (size_t)(nxt.pm / g.mt_per_group) * gstepB + (size_t)nxt.pn * tstepB : cB;
        for (int t = 0; t < nt; t += 2) {
            const bool last = (t == nt - 2);
            const char* a1 = cA + (size_t)(t + 1) * kstep;
            const char* a2 = last ? nA : cA + (size_t)(t + 2) * kstep; const char* b2 = last ? nB : cB + (size_t)(t + 2) * kstep;
            const char* a3 = a2 + kstep; const char* b3 = b2 + kstep;
            if (last && has_next) S.a_ready(nxt);
            if constexpr (GATHER) { if (last) { sG0[0] = nG0[0]; sG0[1] = nG0[1]; sG1[0] = nG1[0]; sG1[1] = nG1[1]; } else { sG0[0] = cG0[0]; sG0[1] = cG0[1]; sG1[0] = cG1[0]; sG1[1] = cG1[1]; } }
            if constexpr (SP2) {
            PG8_LDB(B0, 0, 0); PG8_LDB(B1, 0, 1); PG8_SCHED; PG8_LDA(At, 0, 0); PG8_STAGE(PG8_SA(1, 1), a1 + hstepA, PG8_VC1);
            PG8_WAIT_V(8); PG8_WAIT_L(0); PG8_BAR; PG8_MMA(0, 0, At, B0); PG8_MMA(0, 1, At, B1); PG8_BAR; PG8_SCHED;
            PG8_LDA(At, 0, 1); PG8_STAGE(PG8_SB(0, 0), b2, voffB); PG8_STAGE(PG8_SB(0, 1), b2 + hstepB, voffB); PG8_STAGE(PG8_SA(0, 0), a2, PG8_VS0);
            PG8_WAIT_V(8); PG8_WAIT_L(0); PG8_BAR; PG8_MMA(1, 0, At, B0); PG8_MMA(1, 1, At, B1); PG8_BAR; PG8_SCHED;
            PG8_LDB(B0, 1, 0); PG8_LDB(B1, 1, 1); PG8_SCHED; PG8_LDA(At, 1, 0); PG8_STAGE(PG8_SA(0, 1), a2 + hstepA, PG8_VS1);
            PG8_WAIT_V(8); PG8_WAIT_L(0); PG8_BAR; PG8_MMA(0, 0, At, B0); PG8_MMA(0, 1, At, B1); PG8_BAR; PG8_SCHED;
            PG8_LDA(At, 1, 1); PG8_STAGE(PG8_SB(1, 0), b3, voffB); PG8_STAGE(PG8_SB(1, 1), b3 + hstepB, voffB); PG8_STAGE(PG8_SA(1, 0), a3, PG8_VS0);
            PG8_WAIT_V(8); PG8_WAIT_L(0); PG8_BAR; PG8_MMA(1, 0, At, B0); PG8_MMA(1, 1, At, B1); PG8_BAR; PG8_SCHED;
            } else {
            PG8_LDB(B0, 0, 0); PG8_SCHED; PG8_LDA(At, 0, 0); PG8_STAGE(PG8_SA(1, 1), a1 + hstepA, voffA);
            PG8_WAIT_L(8); PG8_BAR; PG8_WAIT_L(0); PG8_MMA(0, 0, At, B0); PG8_BAR; PG8_SCHED;
            PG8_LDB(B1, 0, 1); PG8_STAGE(PG8_SB(0, 0), b2, voffB);
            PG8_BAR; PG8_WAIT_L(0); PG8_MMA(0, 1, At, B1); PG8_BAR;
            PG8_LDA(At, 0, 1); PG8_STAGE(PG8_SA(0, 0), a2, voffA);
            PG8_BAR; PG8_WAIT_L(0); PG8_MMA(1, 0, At, B0); PG8_BAR; PG8_SCHED;
            PG8_STAGE(PG8_SB(0, 1), b2 + hstepB, voffB);
            PG8_WAIT_V(6); PG8_BAR; PG8_MMA(1, 1, At, B1); PG8_BAR;
            PG8_LDB(B0, 1, 0); PG8_SCHED; PG8_LDA(At, 1, 0); PG8_STAGE(PG8_SA(0, 1), a2 + hstepA, voffA);
            PG8_WAIT_L(8); PG8_BAR; PG8_WAIT_L(0); PG8_MMA(0, 0, At, B0); PG8_BAR; PG8_SCHED;
            PG8_LDB(B1, 1, 1); PG8_STAGE(PG8_SB(1, 0), b3, voffB);
            PG8_BAR; PG8_WAIT_L(0); PG8_MMA(0, 1, At, B1); PG8_BAR;
            PG8_LDA(At, 1, 1); PG8_STAGE(PG8_SA(1, 0), a3, voffA);
            PG8_BAR; PG8_WAIT_L(0); PG8_MMA(1, 0, At, B0); PG8_BAR; PG8_SCHED;
            PG8_STAGE(PG8_SB(1, 1), b3 + hstepB, voffB);
            PG8_WAIT_V(6); PG8_BAR; PG8_MMA(1, 1, At, B1); PG8_BAR;
            }
        }
        if constexpr (ALIGN_EPI) { if (wr == 0) PG8_BAR; }
        if constexpr (FP8) asm volatile("s_nop 15\n\ts_nop 15" ::: "memory");
        bool midpoint = false;
        if constexpr (CHAIN2) { if (!(ui & 1)) { midpoint = true; E.mid(acc, cur, wr, wc, fr, fq); } }
        if constexpr (!Epi::AFTER_DRAIN) { if (!midpoint) { E(acc, cur, wr, wc, fr, fq); S.done(cur); } }
        if (!has_next) break;
        if (!midpoint) {
#pragma unroll
        for (int a = 0; a < 2; ++a)
#pragma unroll
            for (int b = 0; b < 2; ++b)
#pragma unroll
                for (int m = 0; m < 4; ++m)
#pragma unroll
                    for (int n = 0; n < 2; ++n) acc[a][b][m][n] = (f32x4){0.f, 0.f, 0.f, 0.f};
        }
        cur = nxt; cA = nA; cB = nB; ++ui;
        if constexpr (GATHER) { cG0[0] = sG0[0]; cG0[1] = sG0[1]; cG1[0] = sG1[0]; cG1[1] = sG1[1]; }
        if constexpr (ALIGN_EPI) { if (wr == 1) PG8_BAR; }
    }
    PG8_WAIT_V(0);
    if constexpr (!ALIGN_EPI) { if (wr == 0) PG8_BAR; }
    PG8_BAR;
    if constexpr (Epi::AFTER_DRAIN) { E.fused(acc, cur, wr, wc, fr, fq, lds, wid, lane); S.done(cur); }
#undef PG8_SA
#undef PG8_VC0
#undef PG8_VC1
#undef PG8_VS0
#undef PG8_VS1
#undef PG8_GOFF
#undef PG8_SB
#undef PG8_STAGE
#undef PG8_LDA
#undef PG8_LDB
#undef PG8_MMA
#undef PG8_WAIT_V
#undef PG8_WAIT_L
#undef PG8_BAR
#undef PG8_SCHED
}
}

struct EpiInProj {
    bf16_t *UX, *VB, *GS, *GA; float* PQK;
    __device__ __forceinline__ void one(int m, int n, float v) const {
        if (n < 512) { const int b = m >> 12, t = m & 4095, g = n >> 4; UX[((size_t)g * RG + b * NCH + (t >> CLS)) * UXW + (t & (CL - 1)) * 16 + (n & 15)] = (bf16_t)f2bf(v); }
        else if (n < 1152) PQK[(size_t)m * 640 + (n - 512)] = v;
        else if (n < 1280) VB[(size_t)m * 128 + (n - 1152)] = (bf16_t)f2bf(v);
        else if (n < 2304) GS[(size_t)m * 1024 + (n - 1280)] = (bf16_t)f2bf(sigmoidf_(v));
        else GA[(size_t)m * 1024 + (n - 2304)] = (bf16_t)f2bf(sigmoidf_(v));
    }
    __device__ __forceinline__ void operator()(int, int m, int n0, int j, float v0, float v1) const { one(m, n0 + j, v0); one(m, n0 + 128 + j, v1); }
};
struct EpiGlu {
    const bf16_t* Z; bf16_t* SO; const float* bias;
    __device__ __forceinline__ void one(int m, int n, float v) const { const float z = bf2f(Z[(size_t)m * 512 + n]); SO[(size_t)m * 512 + n] = (bf16_t)f2bf(z * sigmoidf_(v + bias[n])); }
    __device__ __forceinline__ void operator()(int, int m, int n0, int j, float v0, float v1) const { one(m, n0 + j, v0); one(m, n0 + 128 + j, v1); }
};
template <bool ADD> struct EpiUp {
    const bf16_t* G; bf16_t* MG;
    __device__ __forceinline__ void one(int m, int n, float v) const {
        const size_t i = (size_t)m * 1024 + n; float r = bf2f(G[i]) * v; if (ADD) r += bf2f(MG[i]); MG[i] = (bf16_t)f2bf(r);
    }
    __device__ __forceinline__ void operator()(int, int m, int n0, int j, float v0, float v1) const { one(m, n0 + j, v0); one(m, n0 + 128 + j, v1); }
};
struct EpiOut {
    const float* xin; float* XR; const float* mod_l;
    __device__ __forceinline__ void one(int m, int n, float v) const { const int b = m >> 12; const size_t i = (size_t)m * 1024 + n; XR[i] = xin[i] + mod_l[(size_t)b * 6144 + 2048 + n] * v; }
    __device__ __forceinline__ void operator()(int, int m, int n0, int j, float v0, float v1) const { one(m, n0 + j, v0); one(m, n0 + 128 + j, v1); }
};
struct EpiMoe1 {
    bf16_t* HID;
    __device__ __forceinline__ void operator()(int g, int m, int n0, int j, float v0, float v1) const { HID[((size_t)g * 2048 + m) * 2048 + (n0 >> 1) + j] = (bf16_t)f2bf(siluf_(v0) * v1); }
};
struct EpiMoe2 {
    bf16_t* YE; const float* GATE;
    __device__ __forceinline__ void one(int g, int m, int n, float v) const { const int b = m >> 9, c = m & 511; YE[((size_t)g * 2048 + m) * 1024 + n] = (bf16_t)f2bf(v * GATE[(size_t)(b * 16 + g) * 512 + c]); }
    __device__ __forceinline__ void operator()(int g, int m, int n0, int j, float v0, float v1) const { one(g, m, n0 + j, v0); one(g, m, n0 + 128 + j, v1); }
};

#define ACC_ARG const f32x4 (&acc)[2][2][4][2]
__device__ __forceinline__ v4u pack8(const f32x4 a, const f32x4 b) { v4u w; w.x = pk2(a.x, a.y); w.y = pk2(a.z, a.w); w.z = pk2(b.x, b.y); w.w = pk2(b.z, b.w); return w; }
__device__ __forceinline__ void unpack8(const v4u w, f32x4& a, f32x4& b) { a.x = lo16(w.x); a.y = hi16(w.x); a.z = lo16(w.y); a.w = hi16(w.y); b.x = lo16(w.z); b.y = hi16(w.z); b.z = lo16(w.w); b.w = hi16(w.w); }
__device__ __forceinline__ f32x4 exp2_4(const f32x4 t) { f32x4 e; e.x = __builtin_amdgcn_exp2f(t.x); e.y = __builtin_amdgcn_exp2f(t.y); e.z = __builtin_amdgcn_exp2f(t.z); e.w = __builtin_amdgcn_exp2f(t.w); return e; }
__device__ __forceinline__ f32x4 rcp4(const f32x4 d) { f32x4 r; r.x = __builtin_amdgcn_rcpf(d.x); r.y = __builtin_amdgcn_rcpf(d.y); r.z = __builtin_amdgcn_rcpf(d.z); r.w = __builtin_amdgcn_rcpf(d.w); return r; }
__device__ __forceinline__ f32x4 sig4s(const f32x4 v, const float scale) { return rcp4(exp2_4(v * (-1.4426950408889634f * scale)) + 1.0f); }
__device__ __forceinline__ f32x4 sig4(const f32x4 v) { return sig4s(v, 1.0f); }
__device__ __forceinline__ f32x4 silu4(const f32x4 v) { return v * sig4(v); }
template <int LOG2S> __device__ __forceinline__ f32x4 silu_mul_scaled(const f32x4 g, const f32x4 u) {
    constexpr float s = (float)(1 << LOG2S), s2 = s * s;
    return (g * u) * rcp4(exp2_4(g * (-1.4426950408889634f / s) + (float)(2 * LOG2S)) + s2);
}

struct XEpiOut {
    static constexpr bool PERM = false, AFTER_DRAIN = false;
    const float* xin; float* XR; const float* mod_l;
    __device__ __forceinline__ void operator()(ACC_ARG, const pg8::Unit& u, int wr, int wc, int fr, int fq) const {
        constexpr int XD = 3;
        const int b = (u.pm * 256) >> 12;
        f32x4 gv[4], xq[XD][4];
#pragma unroll
        for (int q = 0; q < 4; ++q) gv[q] = *(const f32x4*)(mod_l + (size_t)b * 6144 + 2048 + u.pn * 256 + (q >> 1) * 128 + wc * 32 + (q & 1) * 16 + 4 * fq);
#define XLD(g8_, dst_) do { const int row_ = u.pm * 256 + ((g8_) >> 2) * 128 + wr * 64 + ((g8_) & 3) * 16 + fr; _Pragma("unroll") for (int q = 0; q < 4; ++q) \
            dst_[q] = *(const f32x4*)(xin + (size_t)row_ * 1024 + u.pn * 256 + (q >> 1) * 128 + wc * 32 + (q & 1) * 16 + 4 * fq); } while (0)
#pragma unroll
        for (int g8 = 0; g8 < XD; ++g8) XLD(g8, xq[g8]);
#pragma unroll
        for (int g8 = 0; g8 < 8; ++g8) {
            const int ai = g8 >> 2, m = g8 & 3, row = u.pm * 256 + ai * 128 + wr * 64 + m * 16 + fr;
#pragma unroll
            for (int q = 0; q < 4; ++q) {
                const int col = u.pn * 256 + (q >> 1) * 128 + wc * 32 + (q & 1) * 16 + 4 * fq;
                *(f32x4*)(XR + (size_t)row * 1024 + col) = xq[g8 % XD][q] + gv[q] * acc[ai][q >> 1][m][q & 1];
            }
            if (g8 + XD < 8) XLD(g8 + XD, xq[g8 % XD]);
        }
#undef XLD
    }
};
struct XEpiGlu {
    static constexpr bool PERM = true, AFTER_DRAIN = false;
    const bf16_t* Z; bf16_t* SO; const float* bias;
    __device__ __forceinline__ void operator()(ACC_ARG, const pg8::Unit& u, int wr, int wc, int fr, int fq) const {
        constexpr int ZD = 4;
        f32x4 bb[2][2]; v4u zq[ZD][2];
#pragma unroll
        for (int bj = 0; bj < 2; ++bj) { const int col = u.pn * 256 + bj * 128 + wc * 32 + 8 * fq; bb[bj][0] = *(const f32x4*)(bias + col); bb[bj][1] = *(const f32x4*)(bias + col + 4); }
#define ZLD(g8_, dst_) do { const int row_ = u.pm * 256 + ((g8_) >> 2) * 128 + wr * 64 + ((g8_) & 3) * 16 + fr; _Pragma("unroll") for (int bj = 0; bj < 2; ++bj) \
            dst_[bj] = *(const v4u*)(Z + (size_t)row_ * 512 + u.pn * 256 + bj * 128 + wc * 32 + 8 * fq); } while (0)
#pragma unroll
        for (int g8 = 0; g8 < ZD; ++g8) ZLD(g8, zq[g8]);
#pragma unroll
        for (int g8 = 0; g8 < 8; ++g8) {
            const int ai = g8 >> 2, m = g8 & 3, row = u.pm * 256 + ai * 128 + wr * 64 + m * 16 + fr;
#pragma unroll
            for (int bj = 0; bj < 2; ++bj) {
                const int col = u.pn * 256 + bj * 128 + wc * 32 + 8 * fq; const size_t i = (size_t)row * 512 + col;
                f32x4 z0, z1; unpack8(zq[g8 % ZD][bj], z0, z1);
                *(v4u*)(SO + i) = pack8(z0 * sig4(acc[ai][bj][m][0] + bb[bj][0]), z1 * sig4(acc[ai][bj][m][1] + bb[bj][1]));
            }
            if (g8 + ZD < 8) ZLD(g8 + ZD, zq[g8 % ZD]);
        }
#undef ZLD
    }
};
template <bool ADD> struct XEpiUp {
    static constexpr bool PERM = true, AFTER_DRAIN = false;
    const bf16_t* G; bf16_t* MG;
    __device__ __forceinline__ void operator()(ACC_ARG, const pg8::Unit& u, int wr, int wc, int fr, int fq) const {
#pragma unroll
        for (int ai = 0; ai < 2; ++ai)
#pragma unroll
            for (int m = 0; m < 4; ++m) {
                const int row = u.pm * 256 + ai * 128 + wr * 64 + m * 16 + fr;
#pragma unroll
                for (int bj = 0; bj < 2; ++bj) {
                    const int col = u.pn * 256 + bj * 128 + wc * 32 + 8 * fq; const size_t i = (size_t)row * 1024 + col;
                    f32x4 g0, g1; unpack8(*(const v4u*)(G + i), g0, g1);
                    f32x4 r0 = g0 * acc[ai][bj][m][0], r1 = g1 * acc[ai][bj][m][1];
                    if (ADD) { f32x4 p0, p1; unpack8(*(const v4u*)(MG + i), p0, p1); r0 += p0; r1 += p1; }
                    *(v4u*)(MG + i) = pack8(r0, r1);
                }
            }
    }
};
struct XEpiMoe1 {
    static constexpr bool PERM = true, AFTER_DRAIN = false;
    bf16_t* HID;
    __device__ __forceinline__ void operator()(ACC_ARG, const pg8::Unit& u, int wr, int wc, int fr, int fq) const {
#pragma unroll
        for (int ai = 0; ai < 2; ++ai)
#pragma unroll
            for (int m = 0; m < 4; ++m) {
                const int row = u.pm * 256 + ai * 128 + wr * 64 + m * 16 + fr;
                const int col = u.pn * 128 + wc * 32 + 8 * fq;
                *(v4u*)(HID + (size_t)row * 2048 + col) = pack8(silu4(acc[ai][0][m][0]) * acc[ai][1][m][0], silu4(acc[ai][0][m][1]) * acc[ai][1][m][1]);
            }
    }
};
struct XEpiMoe1F8 {
    static constexpr bool PERM = true, AFTER_DRAIN = false;
    unsigned char* HID;
    __device__ __forceinline__ void operator()(ACC_ARG, const pg8::Unit& u, int wr, int wc, int fr, int fq) const {
        asm volatile("" : "+v"(fr), "+v"(fq));
        constexpr float is = 1.0f / FP8_WSCALE;
#pragma unroll
        for (int ai = 0; ai < 2; ++ai)
#pragma unroll
            for (int m = 0; m < 4; ++m) {
                const int row = u.pm * 256 + ai * 128 + wr * 64 + m * 16 + fr;
                const int col = u.pn * 128 + wc * 32 + 8 * fq;
                const f32x4 h0 = silu_mul_scaled<5>(acc[ai][0][m][0], acc[ai][1][m][0]), h1 = silu_mul_scaled<5>(acc[ai][0][m][1], acc[ai][1][m][1]);
                v2u o; o.x = pk4_fp8(h0.x, h0.y, h0.z, h0.w); o.y = pk4_fp8(h1.x, h1.y, h1.z, h1.w);
                *(v2u*)(HID + (size_t)row * 2048 + col) = o;
            }
    }
};
struct XEpiGatesF8 {
    static constexpr bool PERM = true, AFTER_DRAIN = false;
    bf16_t *GS, *GA;
    __device__ __forceinline__ void operator()(ACC_ARG, const pg8::Unit& u, int wr, int wc, int fr, int fq) const {
        asm volatile("" : "+v"(fr), "+v"(fq));
        constexpr float is = 1.0f / FP8_WSCALE;
        bf16_t* G = u.pn < 4 ? GS : GA; const int cbase = (u.pn & 3) * 256 + wc * 32 + 8 * fq;
#pragma unroll
        for (int ai = 0; ai < 2; ++ai)
#pragma unroll
            for (int m = 0; m < 4; ++m) {
                const int row = u.pm * 256 + ai * 128 + wr * 64 + m * 16 + fr;
#pragma unroll
                for (int bj = 0; bj < 2; ++bj) *(v4u*)(G + (size_t)row * 1024 + cbase + bj * 128) = pack8(sig4(acc[ai][bj][m][0] * is), sig4(acc[ai][bj][m][1] * is));
            }
    }
};
struct XEpiMoe2 {
    static constexpr bool PERM = true, AFTER_DRAIN = false;
    bf16_t* YE; const float* GATE; float oscale;
    __device__ __forceinline__ void operator()(ACC_ARG, const pg8::Unit& u, int wr, int wc, int fr, int fq) const {
        asm volatile("" : "+v"(fr), "+v"(fq));
        float gts[8];
#pragma unroll
        for (int g8 = 0; g8 < 8; ++g8) {
            const int row = u.pm * 256 + (g8 >> 2) * 128 + wr * 64 + (g8 & 3) * 16 + fr, e = row >> 11, r = row & 2047, b = r >> 9, c = r & 511;
            gts[g8] = GATE[(size_t)(b * 16 + e) * 512 + c];
        }
#pragma unroll
        for (int ai = 0; ai < 2; ++ai)
#pragma unroll
            for (int m = 0; m < 4; ++m) {
                const int row = u.pm * 256 + ai * 128 + wr * 64 + m * 16 + fr;
                const float gt = gts[ai * 4 + m] * oscale;
#pragma unroll
                for (int bj = 0; bj < 2; ++bj) {
                    const int col = u.pn * 256 + bj * 128 + wc * 32 + 8 * fq;
                    if (YE_FP8) { const f32x4 y0 = acc[ai][bj][m][0] * (gt * YE_SCALE), y1 = acc[ai][bj][m][1] * (gt * YE_SCALE); v2u o; o.x = pk4_fp8(y0.x, y0.y, y0.z, y0.w); o.y = pk4_fp8(y1.x, y1.y, y1.z, y1.w);
                                  *(v2u*)((unsigned char*)YE + (size_t)row * 1024 + col) = o; }
                    else *(v4u*)(YE + (size_t)row * 1024 + col) = pack8(acc[ai][bj][m][0] * gt, acc[ai][bj][m][1] * gt);
                }
            }
    }
};
struct XEpiInProj {
    static constexpr bool PERM = true, AFTER_DRAIN = false;
    bf16_t *UX, *QB, *KB, *VB, *GS, *GA; const float *rope, *qnw, *knw; int pn_off; float asc;
    __device__ __forceinline__ void operator()(ACC_ARG, const pg8::Unit& u, int wr, int wc, int fr, int fq) const {
        { const int t_ = opaque_tid(); fr = t_ & 15; fq = (t_ >> 4) & 3; }
        const int pn = u.pn + pn_off, row0 = u.pm * 256 + wr * 64 + fr;
        if (pn < 2) {
#pragma unroll
            for (int ai = 0; ai < 2; ++ai)
#pragma unroll
                for (int m = 0; m < 4; ++m) {
                    const int row = row0 + ai * 128 + m * 16, b = row >> 12, t = row & 4095;
#pragma unroll
                    for (int bj = 0; bj < 2; ++bj) {
                        const int c0 = pn * 256 + bj * 128 + wc * 32 + 8 * fq, g = c0 >> 4, ci0 = c0 & 15;
                        *(v4u*)(UX + ((size_t)g * RG + b * NCH + (t >> CLS)) * UXW + (t & (CL - 1)) * 16 + ci0) = pack8(acc[ai][bj][m][0] * asc, acc[ai][bj][m][1] * asc);
                    }
                }
        } else if (pn >= 5) {
            const int col = (pn - 5) * 128 + wc * 32 + 8 * fq;
#pragma unroll
            for (int ai = 0; ai < 2; ++ai)
#pragma unroll
                for (int m = 0; m < 4; ++m) {
                    const int row = row0 + ai * 128 + m * 16;
                    const f32x4 s0 = sig4s(acc[ai][0][m][0], asc), s1 = sig4s(acc[ai][0][m][1], asc);
                    const f32x4 d0 = exp2_4(acc[ai][1][m][0] * (-1.4426950408889634f * asc)) + 1.0f, d1 = exp2_4(acc[ai][1][m][1] * (-1.4426950408889634f * asc)) + 1.0f;
                    const f32x4 a0 = rcp4(d0), a1 = rcp4(d1);
                    f32x4 c0, c1;
                    c0.x = fminf(d0.x, 1e20f); c0.y = fminf(d0.y, 1e20f); c0.z = fminf(d0.z, 1e20f); c0.w = fminf(d0.w, 1e20f);
                    c1.x = fminf(d1.x, 1e20f); c1.y = fminf(d1.y, 1e20f); c1.z = fminf(d1.z, 1e20f); c1.w = fminf(d1.w, 1e20f);
                    *(v4u*)(GS + (size_t)row * 1024 + col) = pack8(s0 * c0, s1 * c1);
                    *(v4u*)(GA + (size_t)row * 1024 + col) = pack8(a0, a1);
                }
        } else if (pn == 4 && wc >= 2) {
#pragma unroll
            for (int ai = 0; ai < 2; ++ai)
#pragma unroll
                for (int m = 0; m < 4; ++m) {
                    const int row = row0 + ai * 128 + m * 16;
#pragma unroll
                    for (int bj = 0; bj < 2; ++bj) *(v4u*)(VB + (size_t)row * 128 + (wc - 2) * 64 + bj * 32 + 8 * fq) = pack8(acc[ai][bj][m][0] * asc, acc[ai][bj][m][1] * asc);
                }
        } else {
            const bool isq = pn < 4; const int h = isq ? (pn - 2) * 4 + wc : wc;
            const float* nw = isq ? qnw : knw; const float osc = isq ? QSCALE : 1.0f;
            const int d1 = (fq & 2) * 16 + (fq & 1) * 8, i0 = (fq & 1) * 8, lane = fq * 16 + fr;
            const f32x4 w1a = *(const f32x4*)(nw + d1), w1b = *(const f32x4*)(nw + d1 + 4), w2a = *(const f32x4*)(nw + d1 + 16), w2b = *(const f32x4*)(nw + d1 + 20);
            bf16_t* dst = (isq ? QB : KB) + h * 64 + d1; const int pitch = isq ? 512 : 128;
#pragma unroll
            for (int ai = 0; ai < 2; ++ai)
#pragma unroll
                for (int m = 0; m < 4; ++m) {
                    const int row = row0 + ai * 128 + m * 16, t = row & 4095, pos = (fq & 2) ? (t & 63) : (t >> 6);
                    const f32x4 x1a = acc[ai][0][m][0] * asc, x1b = acc[ai][0][m][1] * asc, x2a = acc[ai][1][m][0] * asc, x2b = acc[ai][1][m][1] * asc;
                    float ss = x1a.x * x1a.x + x1a.y * x1a.y + x1a.z * x1a.z + x1a.w * x1a.w + x1b.x * x1b.x + x1b.y * x1b.y + x1b.z * x1b.z + x1b.w * x1b.w
                             + x2a.x * x2a.x + x2a.y * x2a.y + x2a.z * x2a.z + x2a.w * x2a.w + x2b.x * x2b.x + x2b.y * x2b.y + x2b.z * x2b.z + x2b.w * x2b.w;
                    ss += __int_as_float(__builtin_amdgcn_ds_bpermute((lane ^ 16) << 2, __float_as_int(ss)));
                    ss += __int_as_float(__builtin_amdgcn_ds_bpermute((lane ^ 32) << 2, __float_as_int(ss)));
                    const float r = rsqrtf(ss * (1.0f / 64.0f) + EPS);
                    const f32x4* rp = (const f32x4*)(rope + (size_t)(pos * 16 + i0) * 2);
                    const f32x4 cs0 = rp[0], cs1 = rp[1], cs2 = rp[2], cs3 = rp[3];
                    const f32x4 n1a = x1a * r * w1a, n1b = x1b * r * w1b, n2a = x2a * r * w2a, n2b = x2b * r * w2b;
                    f32x4 o1a, o1b, o2a, o2b;
                    o1a.x = n1a.x * cs0.x - n2a.x * cs0.y; o2a.x = n1a.x * cs0.y + n2a.x * cs0.x;
                    o1a.y = n1a.y * cs0.z - n2a.y * cs0.w; o2a.y = n1a.y * cs0.w + n2a.y * cs0.z;
                    o1a.z = n1a.z * cs1.x - n2a.z * cs1.y; o2a.z = n1a.z * cs1.y + n2a.z * cs1.x;
                    o1a.w = n1a.w * cs1.z - n2a.w * cs1.w; o2a.w = n1a.w * cs1.w + n2a.w * cs1.z;
                    o1b.x = n1b.x * cs2.x - n2b.x * cs2.y; o2b.x = n1b.x * cs2.y + n2b.x * cs2.x;
                    o1b.y = n1b.y * cs2.z - n2b.y * cs2.w; o2b.y = n1b.y * cs2.w + n2b.y * cs2.z;
                    o1b.z = n1b.z * cs3.x - n2b.z * cs3.y; o2b.z = n1b.z * cs3.y + n2b.z * cs3.x;
                    o1b.w = n1b.w * cs3.z - n2b.w * cs3.w; o2b.w = n1b.w * cs3.w + n2b.w * cs3.z;
                    bf16_t* dp = dst + (size_t)row * pitch;
                    *(v4u*)dp = pack8(o1a * osc, o1b * osc); *(v4u*)(dp + 16) = pack8(o2a * osc, o2b * osc);
                }
        }
    }
};
struct XEpiSloc {
    static constexpr bool PERM = false, AFTER_DRAIN = false;
    float* SLOC;
    __device__ __forceinline__ void operator()(ACC_ARG, const pg8::Unit& u, int wr, int wc, int fr, int fq) const {
#pragma unroll
        for (int ai = 0; ai < 2; ++ai)
#pragma unroll
            for (int m = 0; m < 4; ++m) {
                const int row = u.pm * 256 + ai * 128 + wr * 64 + m * 16 + fr;
#pragma unroll
                for (int bj = 0; bj < 2; ++bj)
#pragma unroll
                    for (int n = 0; n < 2; ++n) *(f32x4*)(SLOC + (size_t)row * 256 + u.pn * 256 + bj * 128 + wc * 32 + n * 16 + 4 * fq) = acc[ai][bj][m][n];
            }
    }
};
__device__ __forceinline__ float gelu_fast(float y) { return y * __builtin_amdgcn_rcpf(1.0f + __builtin_amdgcn_exp2f(-2.3022082f * (y + 0.044715f * y * y * y))); }
__device__ __forceinline__ f32x4 gelu4(const f32x4 v) { return v * rcp4(exp2_4(v * (v * v * (-2.3022082f * 0.044715f) + -2.3022082f)) + 1.0f); }
struct XEpiZ {
    static constexpr bool PERM = true, AFTER_DRAIN = false;
    bf16_t* Z;
    __device__ __forceinline__ void operator()(ACC_ARG, const pg8::Unit& u, int wr, int wc, int fr, int fq) const {
#pragma unroll
        for (int ai = 0; ai < 2; ++ai)
#pragma unroll
            for (int m = 0; m < 4; ++m) {
                const int row = u.pm * 256 + ai * 128 + wr * 64 + m * 16 + fr, g = row / RG, b = (row / NCH) % NB, ch = row % NCH;
#pragma unroll
                for (int bj = 0; bj < 2; ++bj) {
                    const int c0 = u.pn * 256 + bj * 128 + wc * 32 + 8 * fq, t = c0 >> 4, co0 = c0 & 15;
                    *(v4u*)(Z + ((size_t)b * 4096 + ch * CL + t) * 512 + g * 16 + co0) = pack8(gelu4(acc[ai][bj][m][0]), gelu4(acc[ai][bj][m][1]));
                }
            }
    }
};
struct InProjF8Order {
    pg8::StaticOrder so; int c;
    __device__ __forceinline__ bool next(int i, pg8::Unit& u) const {
        long L = -1;
        if (i < 2) L = c + 256 * i;
        else if (c >= 128 && c < 192) { if (i == 2) L = 512 + c; else if (i == 3) L = 384 + c; }
        else if (c >= 192) { if (i == 2) L = 384 + c; }
        return so.at(L, u);
    }
    __device__ __forceinline__ void a_ready(const pg8::Unit&) const {}
    __device__ __forceinline__ void done(const pg8::Unit&) const {}
};
struct OneUnitOrder {
    int n, pm;
    __device__ __forceinline__ bool next(int i, pg8::Unit& u) const { if (i > 0 || (int)blockIdx.x >= n) return false; u.pm = pm; u.pn = 0; return true; }
    __device__ __forceinline__ void a_ready(const pg8::Unit&) const {}
    __device__ __forceinline__ void done(const pg8::Unit&) const {}
};
struct XEpiUpChain {
    static constexpr bool PERM = true, AFTER_DRAIN = false;
    const bf16_t *GS, *GA; bf16_t* MG;
    __device__ __forceinline__ void mid(f32x4 (&acc)[2][2][4][2], const pg8::Unit& u, int wr, int wc, int fr, int fq) const {
        asm volatile("" : "+v"(fr), "+v"(fq));
        constexpr int MD = 4;
        v4u sq[MD][2];
#define MLD(g8_, k_) do { const int row_ = u.pm * 256 + ((g8_) >> 2) * 128 + wr * 64 + ((g8_) & 3) * 16 + fr; _Pragma("unroll") for (int bj = 0; bj < 2; ++bj) \
            sq[k_][bj] = *(const v4u*)(GS + (size_t)row_ * 1024 + u.pn * 256 + bj * 128 + wc * 32 + 8 * fq); } while (0)
#pragma unroll
        for (int g8 = 0; g8 < MD; ++g8) MLD(g8, g8);
#pragma unroll
        for (int g8 = 0; g8 < 8; ++g8) {
            const int ai = g8 >> 2, m = g8 & 3;
#pragma unroll
            for (int bj = 0; bj < 2; ++bj) { f32x4 q0, q1; unpack8(sq[g8 % MD][bj], q0, q1); acc[ai][bj][m][0] *= q0; acc[ai][bj][m][1] *= q1; }
            if (g8 + MD < 8) MLD(g8 + MD, g8 % MD);
            asm volatile("" ::: "memory");
        }
#undef MLD
    }
    __device__ __forceinline__ void operator()(ACC_ARG, const pg8::Unit& u, int wr, int wc, int fr, int fq) const {
        asm volatile("" : "+v"(fr), "+v"(fq));
        constexpr int UD = 4;
        v4u gq[UD][2];
#define ULD(g8_, k_) do { const int row_ = u.pm * 256 + ((g8_) >> 2) * 128 + wr * 64 + ((g8_) & 3) * 16 + fr; _Pragma("unroll") for (int bj = 0; bj < 2; ++bj) \
            gq[k_][bj] = *(const v4u*)(GA + (size_t)row_ * 1024 + u.pn * 256 + bj * 128 + wc * 32 + 8 * fq); } while (0)
#pragma unroll
        for (int g8 = 0; g8 < UD; ++g8) ULD(g8, g8);
#pragma unroll
        for (int ai = 0; ai < 2; ++ai)
#pragma unroll
            for (int m = 0; m < 4; ++m) {
                const int row = u.pm * 256 + ai * 128 + wr * 64 + m * 16 + fr, g8 = ai * 4 + m;
#pragma unroll
                for (int bj = 0; bj < 2; ++bj) {
                    const int col = u.pn * 256 + bj * 128 + wc * 32 + 8 * fq; const size_t i = (size_t)row * 1024 + col;
                    f32x4 a0, a1; unpack8(gq[g8 % UD][bj], a0, a1);
                    a0.x = fmaxf(a0.x, 1e-20f); a0.y = fmaxf(a0.y, 1e-20f); a0.z = fmaxf(a0.z, 1e-20f); a0.w = fmaxf(a0.w, 1e-20f);
                    a1.x = fmaxf(a1.x, 1e-20f); a1.y = fmaxf(a1.y, 1e-20f); a1.z = fmaxf(a1.z, 1e-20f); a1.w = fmaxf(a1.w, 1e-20f);
                    *(v4u*)(MG + i) = pack8(acc[ai][bj][m][0] * a0, acc[ai][bj][m][1] * a1);
                }
                if (g8 + UD < 8) ULD(g8 + UD, g8 % UD);
            }
#undef ULD
    }
};
struct FixedUnit2 {
    int pm, pn;
    __device__ __forceinline__ bool next(int i, pg8::Unit& u) const { if (i > 1) return false; u.pm = pm; u.pn = pn; return true; }
    __device__ __forceinline__ void a_ready(const pg8::Unit&) const {}
    __device__ __forceinline__ void done(const pg8::Unit&) const {}
};
template <class Epi, bool ALIGN>
__device__ __forceinline__ void run_gemm(float* lds, const bf16_t* A, int lda, const bf16_t* Bt, int ldb, int M, int N, int K, int mt_per_group, size_t strideB, const Epi& e) {
    pg8::Gemm g{A, Bt, M, N, K, lda, ldb, mt_per_group, strideB, nullptr, nullptr, nullptr};
    pg8::StaticOrder S; S.init(M, N, (int)gridDim.x, opaque_bid());
    pg8::gemm_phase<Epi, pg8::StaticOrder, ALIGN, true>((PG8_LAS unsigned char*)lds, g, S, e);
}

__device__ __forceinline__ void phase_qkpost(const Params& p, int l) {
    const float* PQK = (const float*)(p.ws + WS_PQK);
    bf16_t* QB = (bf16_t*)(p.ws + WS_QB); bf16_t* KB = (bf16_t*)(p.ws + WS_KB);
    const int total = T * 10;
    for (int i = blockIdx.x * NTHREADS + opaque_tid(); i < total; i += gridDim.x * NTHREADS) {
        const int m = i / 10, j = i % 10, t = m & 4095;
        const float* src = PQK + (size_t)m * 640 + j * 64;
        const float* nw = (j < 8 ? p.q_norm_w : p.k_norm_w) + l * 64;
        float xv[64]; float ss = 0.f;
#pragma unroll
        for (int d = 0; d < 64; ++d) { xv[d] = src[d]; ss += xv[d] * xv[d]; }
        const float r = rsqrtf(ss * (1.0f / 64.0f) + EPS);
#pragma unroll
        for (int d = 0; d < 64; ++d) xv[d] = xv[d] * r * nw[d];
        const float posr = (float)(t >> 6), posc = (float)(t & 63);
        const float osc = (j < 8) ? QSCALE : 1.0f;
        bf16_t* dst = (j < 8) ? (QB + (size_t)m * 512 + j * 64) : (KB + (size_t)m * 128 + (j - 8) * 64);
#pragma unroll
        for (int d = 0; d < 16; ++d) {
            const float inv = exp2f(-(float)d * (13.287712379549449f / 16.0f));
            float sr, cr, sc, cc; sincosf(posr * inv, &sr, &cr); sincosf(posc * inv, &sc, &cc);
            const float a1 = xv[d], a2 = xv[16 + d], b1 = xv[32 + d], b2 = xv[48 + d];
            dst[d] = (bf16_t)f2bf((a1 * cr - a2 * sr) * osc); dst[16 + d] = (bf16_t)f2bf((a1 * sr + a2 * cr) * osc);
            dst[32 + d] = (bf16_t)f2bf((b1 * cc - b2 * sc) * osc); dst[48 + d] = (bf16_t)f2bf((b1 * sc + b2 * cc) * osc);
        }
    }
}

namespace attn_body {
using bf16=__hip_bfloat16;
using bf16x8=__attribute__((ext_vector_type(8)))short;
using s16x4=__attribute__((ext_vector_type(4)))short;
using f32x16=__attribute__((ext_vector_type(16)))float;
using u32x4=__attribute__((ext_vector_type(4)))unsigned;
constexpr int SEQ=4096,D=64,QP=512,KP=128;
constexpr int NW=8,QBLK=32,QB=QBLK*NW,KVBLK=64,NQB=SEQ/QB;
__device__ __forceinline__ int crow(int r,int hi){return (r&3)+8*(r>>2)+4*hi;}
#define SBAR() __builtin_amdgcn_sched_barrier(0)
constexpr int NSLOT=3, SLOTB=8192;
constexpr int LDS_K=0, LDS_V=NSLOT*SLOTB, LDS_WS=2*NSLOT*SLOTB, LDS_OST=LDS_WS+NW*64*4, LDS_BYTES=LDS_OST+NW*4096;
constexpr float C2=0.125f*1.4426950408889634f;
__device__ __forceinline__ void glds16(const void*gsrc,unsigned lds_dst){unsigned keep;
  asm volatile("s_mov_b32 %0, m0\n\ts_mov_b32 m0, %2\n\ts_nop 0\n\tglobal_load_lds_dwordx4 %1, off\n\ts_mov_b32 m0, %0":"=&s"(keep):"v"(gsrc),"s"(lds_dst):"memory");}
__device__ __forceinline__ float max3f(float a,float b,float c){float r;asm("v_max3_f32 %0, %1, %2, %3":"=v"(r):"v"(a),"v"(b),"v"(c));return r;}
__device__ __forceinline__ float max2f(float a,float b){float r;asm("v_max_f32_e32 %0, %1, %2":"=v"(r):"v"(a),"v"(b));return r;}
__device__ __forceinline__ float fadd_s(float a,float b){float r;asm("v_add_f32_e32 %0, %1, %2":"=v"(r):"v"(a),"v"(b));return r;}
__device__ __forceinline__ float fsub_s(float a,float b){float r;asm("v_sub_f32_e32 %0, %1, %2":"=v"(r):"v"(a),"v"(b));return r;}
typedef float f32x2_t __attribute__((ext_vector_type(2))); typedef __bf16 bf16x2_t __attribute__((ext_vector_type(2)));
__device__ __forceinline__ unsigned cvtpk_s(float lo,float hi){f32x2_t v={lo,hi};bf16x2_t b=__builtin_convertvector(v,bf16x2_t);return __builtin_bit_cast(unsigned,b);}
#define WAIT_BAR(N) asm volatile("s_waitcnt vmcnt(" #N ") lgkmcnt(0)\n\ts_barrier":::"memory")

__device__ __forceinline__ void qkt(f32x16&p0,f32x16&p1,const char*Kslot,const bf16x8*qr,const f32x16&negm,int r32,int hi){
  const char*kb=Kslot+hi*1024+r32*16;
  #pragma unroll
  for(int d0=0;d0<4;++d0){
    const bf16x8 b0=*reinterpret_cast<const bf16x8*>(kb+d0*2048);
    const bf16x8 b1=*reinterpret_cast<const bf16x8*>(kb+d0*2048+512);
    if(d0==0){p0=__builtin_amdgcn_mfma_f32_32x32x16_bf16(b0,qr[0],negm,0,0,0);p1=__builtin_amdgcn_mfma_f32_32x32x16_bf16(b1,qr[0],negm,0,0,0);}
    else{p0=__builtin_amdgcn_mfma_f32_32x32x16_bf16(b0,qr[d0],p0,0,0,0);p1=__builtin_amdgcn_mfma_f32_32x32x16_bf16(b1,qr[d0],p1,0,0,0);}}
}
typedef __attribute__((address_space(3))) const char* lds_cptr;
typedef short v4i16_t __attribute__((ext_vector_type(4)));
__device__ __forceinline__ void kload8(bf16x8*kf,lds_cptr kp){
  kf[0]=*(const __attribute__((address_space(3))) bf16x8*)(kp);      kf[1]=*(const __attribute__((address_space(3))) bf16x8*)(kp+512);
  kf[2]=*(const __attribute__((address_space(3))) bf16x8*)(kp+2048); kf[3]=*(const __attribute__((address_space(3))) bf16x8*)(kp+2560);
  kf[4]=*(const __attribute__((address_space(3))) bf16x8*)(kp+4096); kf[5]=*(const __attribute__((address_space(3))) bf16x8*)(kp+4608);
  kf[6]=*(const __attribute__((address_space(3))) bf16x8*)(kp+6144); kf[7]=*(const __attribute__((address_space(3))) bf16x8*)(kp+6656);
}
__device__ __forceinline__ void kload2(bf16x8*kf,lds_cptr kp,int j){ kf[2*j]=*(const __attribute__((address_space(3))) bf16x8*)(kp+j*2048); kf[2*j+1]=*(const __attribute__((address_space(3))) bf16x8*)(kp+j*2048+512); }
__device__ __forceinline__ s16x4 vtr(lds_cptr p){ return __builtin_bit_cast(s16x4,__builtin_amdgcn_ds_read_tr16_b64_v4i16((__attribute__((address_space(3))) v4i16_t*)p)); }
__device__ __forceinline__ float rowmax(const f32x16&p0,const f32x16&p1){
  float a=max3f(p0[0],p0[1],p1[0]),b=max3f(p0[2],p0[3],p1[1]);a=max3f(a,p1[2],p1[3]);
  #pragma unroll
  for(int r=4;r<16;r+=4){a=max3f(a,p0[r],p0[r+1]);b=max3f(b,p0[r+2],p0[r+3]);a=max3f(a,p1[r],p1[r+1]);b=max3f(b,p1[r+2],p1[r+3]);}
  const float m=max2f(a,b);
  auto rr=__builtin_amdgcn_permlane32_swap(__float_as_uint(m),__float_as_uint(m),false,false);
  return max2f(__uint_as_float(rr[0]),__uint_as_float(rr[1]));
}
__device__ __forceinline__ void pv(f32x16*o,int vb,bf16x8 pa0,bf16x8 pa1,bf16x8 pa2,bf16x8 pa3){
  #pragma unroll
  for(int d0=0;d0<2;++d0){s16x4 lo[4],hi[4];
    #pragma unroll
    for(int ks=0;ks<4;++ks){
      asm volatile("ds_read_b64_tr_b16 %0,%1 offset:%c2":"=&v"(lo[ks]):"v"(vb),"i"(d0*4096+ks*1024):"memory");
      asm volatile("ds_read_b64_tr_b16 %0,%1 offset:%c2":"=&v"(hi[ks]):"v"(vb),"i"(d0*4096+ks*1024+512):"memory");}
    asm volatile("s_waitcnt lgkmcnt(0)":::"memory");SBAR();
    #define PK(k) (bf16x8){lo[k][0],lo[k][1],lo[k][2],lo[k][3],hi[k][0],hi[k][1],hi[k][2],hi[k][3]}
    o[d0]=__builtin_amdgcn_mfma_f32_32x32x16_bf16(pa0,PK(0),o[d0],0,0,0);
    o[d0]=__builtin_amdgcn_mfma_f32_32x32x16_bf16(pa1,PK(1),o[d0],0,0,0);
    o[d0]=__builtin_amdgcn_mfma_f32_32x32x16_bf16(pa2,PK(2),o[d0],0,0,0);
    o[d0]=__builtin_amdgcn_mfma_f32_32x32x16_bf16(pa3,PK(3),o[d0],0,0,0);
    #undef PK
  }
}

#ifndef ATTN_STORE16
#define ATTN_STORE16(p,v) (*(u32x4*)(p)=(v))
#endif
template<int THRL> __device__ __forceinline__ void attn_unit(int b,int h,int hkv,int qb,const bf16*Q,const bf16*__restrict__ K,const bf16*__restrict__ V,bf16*O,char*shm,float sbound){
  const int tid=opaque_tid(),lane=tid&63,r32=lane&31,hi=lane>>5; const int wid=__builtin_amdgcn_readfirstlane(tid>>6);
  const long rowbase=(long)b*SEQ; const int q0=qb*QB;
  const bf16*Qw=Q+(rowbase+q0+wid*QBLK)*QP+h*D;
  const bf16*Kh=K+rowbase*KP+hkv*D,*Vh=V+rowbase*KP+hkv*D;
  const unsigned lds0=(unsigned)(uintptr_t)shm;
  float*wsf=(float*)(shm+LDS_WS)+wid*64;
  const bf16*ksrc=Kh+(long)lane*KP+wid*8;
  const bf16*vsrc=Vh+(long)(16*(wid&3)+(lane>>2))*KP+(wid>>2)*32+(lane&3)*8;
  const unsigned kdst=lds0+LDS_K+wid*1024, vdst=lds0+LDS_V+wid*1024;
  #define DMA_K(t,slot) glds16(ksrc+(long)(t)*KVBLK*KP,(unsigned)__builtin_amdgcn_readfirstlane(kdst+(slot)))
  #define DMA_V(t,slot) glds16(vsrc+(long)(t)*KVBLK*KP,(unsigned)__builtin_amdgcn_readfirstlane(vdst+(slot)))
  const int vb0=(int)(lds0+LDS_V)+((lane>>4)&1)*32+(lane&3)*8+(4*hi+((lane&15)>>2))*64;
  const char*Kbase=shm+LDS_K; bf16x8 kf[8];
  const lds_cptr shm3=(lds_cptr)shm; const lds_cptr kp0=shm3+LDS_K+hi*1024+r32*16; const lds_cptr vp0=shm3+LDS_V+((lane>>4)&1)*32+(lane&3)*8+(4*hi+((lane&15)>>2))*64;
  const int NT=SEQ/KVBLK;
  DMA_K(0,0);DMA_V(0,0);DMA_K(1,SLOTB);
  bf16x8 qr[4];
  #pragma unroll
  for(int d0=0;d0<4;++d0)qr[d0]=*reinterpret_cast<const bf16x8*>(&Qw[(long)r32*QP+d0*16+hi*8]);
  float mhat=0.f,l_reg=0.f;f32x16 o[2];o[0]=f32x16{};o[1]=f32x16{};f32x16 negm=f32x16{};
  if(THRL<0){ mhat=sbound; _Pragma("unroll") for(int r=0;r<16;++r)negm[r]=-sbound; }
  asm volatile("":"+v"(negm));
    #define CMASK(P0,P1,t) do{}while(0)
  bool resc=false;
  #define START(P0,P1) do{ resc=false; \
    if(THRL>=0){ const float rm=rowmax(P0,P1); const float dl=rm; mhat=fadd_s(mhat,dl); \
      _Pragma("unroll") for(int r=0;r<16;++r){P0[r]=fsub_s(P0[r],dl);P1[r]=fsub_s(P1[r],dl);} \
      _Pragma("unroll") for(int r=0;r<16;++r)negm[r]=-mhat; asm volatile("":"+v"(negm)); } \
    _Pragma("unroll") for(int r=0;r<16;++r)P0[r]=__builtin_amdgcn_exp2f(P0[r]); }while(0)
  #define RESC() do{ if(resc){ asm volatile("s_waitcnt lgkmcnt(0)":::"memory"); \
      _Pragma("unroll") for(int d_=0;d_<2;++d_) _Pragma("unroll") for(int r=0;r<16;++r)o[d_][r]*=wsf[crow(r,hi)]; } }while(0)
  f32x16 pA0,pA1,pB0,pB1;
  int sl_prev=0,sl_cur=0,sl_next=SLOTB;
  #define ROT() do{sl_prev=sl_cur;sl_cur=sl_next;sl_next=(sl_next==(NSLOT-1)*SLOTB)?0:sl_next+SLOTB;}while(0)
  DMA_K(2,2*SLOTB);
  WAIT_BAR(3);
  qkt(pA0,pA1,Kbase,qr,negm,r32,hi);asm volatile("s_nop 15\n\ts_nop 7":"+v"(pA0),"+v"(pA1));CMASK(pA0,pA1,0);
  START(pA0,pA1);
  _Pragma("unroll") for(int r=0;r<16;++r)pA1[r]=__builtin_amdgcn_exp2f(pA1[r]);
  WAIT_BAR(0);
  DMA_K(3,0);DMA_V(1,SLOTB);
  ROT();
  kload8(kf,kp0+sl_cur);
  WAIT_BAR(2);
  s16x4 vlo[8],vhi[8]; u32x4 pw0,pw1,pw2,pw3;
  #define PKW(P,B) cvtpk_s(P[B],P[B+1])
  #define PAF(k) __builtin_bit_cast(bf16x8,pw##k)
  #define VFR(i) (bf16x8){vlo[i][0],vlo[i][1],vlo[i][2],vlo[i][3],vhi[i][0],vhi[i][1],vhi[i][2],vhi[i][3]}
  #define PIN(x) asm volatile("":"+v"(x))
  #define MX3(a,b,c) __builtin_fmaxf(__builtin_fmaxf((a),(b)),(c))
  #define GAPA(MF,A0,A1,A2,A3,W0,W1,PW) do{ MF; sacc+=A0; sacc+=A1; sacc+=A2; sacc+=A3; PIN(sacc); W0; W1; PIN(PW); SBAR(); }while(0)
  #define EX(v) __builtin_amdgcn_exp2f(v)
  #define GAPB(MF,X,B) do{ MF; X[B]=EX(X[B]); X[B+1]=EX(X[B+1]); X[B+2]=EX(X[B+2]); X[B+3]=EX(X[B+3]); PIN(X); SBAR(); }while(0)
  #define VRD(i) do{ vlo[i]=vtr(vp_+(((i)>>2)*4096+((i)&3)*1024)); vhi[i]=vtr(vp_+(((i)>>2)*4096+((i)&3)*1024+512)); }while(0)
  #define KRD(G,j) do{ if(G){ kload2(kf,kp0+sl_next,j); SBAR(); } }while(0)
  #define STEP(C0,C1,P0,P1,t,GK,GV,GL) do{ SBAR(); \
    const lds_cptr vp_=vp0+sl_prev; \
    VRD(0); SBAR(); float sacc=(P0[0]+P0[1]); \
    GAPA(C0=__builtin_amdgcn_mfma_f32_32x32x16_bf16(kf[0],qr[0],negm,0,0,0), P0[2],P0[3],P0[4],P0[5],     pw0[0]=PKW(P0,0), pw0[1]=PKW(P0,2), pw0); \
    VRD(4); SBAR(); GAPA(C1=__builtin_amdgcn_mfma_f32_32x32x16_bf16(kf[1],qr[0],negm,0,0,0), P0[6],P0[7],P0[8],P0[9],     pw0[2]=PKW(P0,4), pw0[3]=PKW(P0,6), pw0); \
    VRD(1); SBAR(); GAPA(C0=__builtin_amdgcn_mfma_f32_32x32x16_bf16(kf[2],qr[1],C0,0,0,0),   P0[10],P0[11],P0[12],P0[13], pw1[0]=PKW(P0,8), pw1[1]=PKW(P0,10), pw1); \
    VRD(5); SBAR(); GAPA(C1=__builtin_amdgcn_mfma_f32_32x32x16_bf16(kf[3],qr[1],C1,0,0,0),   P0[14],P0[15],P1[0],P1[1],   pw1[2]=PKW(P0,12),pw1[3]=PKW(P0,14), pw1); \
    VRD(2); SBAR(); GAPA(C0=__builtin_amdgcn_mfma_f32_32x32x16_bf16(kf[4],qr[2],C0,0,0,0),   P1[2],P1[3],P1[4],P1[5],     pw2[0]=PKW(P1,0), pw2[1]=PKW(P1,2), pw2); \
    VRD(6); SBAR(); GAPA(C1=__builtin_amdgcn_mfma_f32_32x32x16_bf16(kf[5],qr[2],C1,0,0,0),   P1[6],P1[7],P1[8],P1[9],     pw2[2]=PKW(P1,4), pw2[3]=PKW(P1,6), pw2); \
    VRD(3); SBAR(); GAPA(C0=__builtin_amdgcn_mfma_f32_32x32x16_bf16(kf[6],qr[3],C0,0,0,0),   P1[10],P1[11],P1[12],P1[13], pw3[0]=PKW(P1,8), pw3[1]=PKW(P1,10), pw3); \
    VRD(7); SBAR(); GAPA(C1=__builtin_amdgcn_mfma_f32_32x32x16_bf16(kf[7],qr[3],C1,0,0,0),   P1[14],P1[15],0.f,0.f,       pw3[2]=PKW(P1,12),pw3[3]=PKW(P1,14), pw3); \
    l_reg+=sacc; \
    if(GK){DMA_K((t)+3,sl_cur);} if(GV){DMA_V((t)+1,sl_next);} \
    CMASK(C0,C1,t); \
    if(THRL>=0){ float a=MX3(C0[0],C0[1],C1[0]),b=MX3(C0[2],C0[3],C1[1]); a=MX3(a,C1[2],C1[3]); \
      _Pragma("unroll") for(int r=4;r<16;r+=4){a=MX3(a,C0[r],C0[r+1]);b=MX3(b,C0[r+2],C0[r+3]);a=MX3(a,C1[r],C1[r+1]);b=MX3(b,C1[r+2],C1[r+3]);} \
      float rm=__builtin_fmaxf(a,b); { auto rr=__builtin_amdgcn_permlane32_swap(__float_as_uint(rm),__float_as_uint(rm),false,false); rm=__builtin_fmaxf(__uint_as_float(rr[0]),__uint_as_float(rr[1])); } \
      resc=false; \
      if(__builtin_expect(__any(rm>(float)THRL),0)){ const float dl=__builtin_fmaxf(rm,0.f); mhat+=dl; \
        _Pragma("unroll") for(int r=0;r<16;++r){C0[r]-=dl;C1[r]-=dl;} \
        _Pragma("unroll") for(int r=0;r<16;++r)negm[r]=-mhat; asm volatile("":"+v"(negm)); \
        const float f=__builtin_amdgcn_exp2f(-dl); l_reg*=f; if(hi==0)wsf[r32]=f; resc=true; } } \
    SBAR(); \
    GAPB(o[0]=__builtin_amdgcn_mfma_f32_32x32x16_bf16(PAF(0),VFR(0),o[0],0,0,0), C0,0); \
    GAPB(o[1]=__builtin_amdgcn_mfma_f32_32x32x16_bf16(PAF(0),VFR(4),o[1],0,0,0), C0,4); \
    KRD(GL,0); GAPB(o[0]=__builtin_amdgcn_mfma_f32_32x32x16_bf16(PAF(1),VFR(1),o[0],0,0,0), C0,8); \
    KRD(GL,1); GAPB(o[1]=__builtin_amdgcn_mfma_f32_32x32x16_bf16(PAF(1),VFR(5),o[1],0,0,0), C0,12); \
    KRD(GL,2); GAPB(o[0]=__builtin_amdgcn_mfma_f32_32x32x16_bf16(PAF(2),VFR(2),o[0],0,0,0), C1,0); \
    KRD(GL,3); GAPB(o[1]=__builtin_amdgcn_mfma_f32_32x32x16_bf16(PAF(2),VFR(6),o[1],0,0,0), C1,4); \
    GAPB(o[0]=__builtin_amdgcn_mfma_f32_32x32x16_bf16(PAF(3),VFR(3),o[0],0,0,0), C1,8); \
    GAPB(o[1]=__builtin_amdgcn_mfma_f32_32x32x16_bf16(PAF(3),VFR(7),o[1],0,0,0), C1,12); \
    }while(0)
  int t=1;
  #undef CMASK
  #define CMASK(P0,P1,t) do{}while(0)
  for(;t+5<NT;t+=2){
    STEP(pB0,pB1,pA0,pA1,t,true,true,true);     WAIT_BAR(2); RESC(); ROT();
    STEP(pA0,pA1,pB0,pB1,t+1,true,true,true);   WAIT_BAR(2); RESC(); ROT();
  }
  #undef CMASK
  #define CMASK(P0,P1,t) do{}while(0)
  #define ENDW(tt) do{ if((tt)+3<NT){WAIT_BAR(2);} else if((tt)+2<NT){WAIT_BAR(1);} else {WAIT_BAR(0);} }while(0)
  for(;t+1<NT;t+=2){
    STEP(pB0,pB1,pA0,pA1,t,(t+3<NT),(t+1<NT),(t+1<NT));       ENDW(t);   RESC(); ROT();
    STEP(pA0,pA1,pB0,pB1,t+1,(t+4<NT),(t+2<NT),(t+2<NT));     ENDW(t+1); RESC(); ROT();
  }
  STEP(pB0,pB1,pA0,pA1,NT-1,false,false,false); RESC();
  { float sacc=pB0[0]+pB0[1]; _Pragma("unroll") for(int r=2;r<16;++r)sacc+=pB0[r]; _Pragma("unroll") for(int r=0;r<16;++r)sacc+=pB1[r]; l_reg+=sacc;
    pw0=(u32x4){PKW(pB0,0),PKW(pB0,2),PKW(pB0,4),PKW(pB0,6)};pw1=(u32x4){PKW(pB0,8),PKW(pB0,10),PKW(pB0,12),PKW(pB0,14)};pw2=(u32x4){PKW(pB1,0),PKW(pB1,2),PKW(pB1,4),PKW(pB1,6)};pw3=(u32x4){PKW(pB1,8),PKW(pB1,10),PKW(pB1,12),PKW(pB1,14)};
    SBAR(); pv(o,vb0+sl_cur,PAF(0),PAF(1),PAF(2),PAF(3)); }
  #undef PKW
  #undef PAF
  #undef VFR
  #undef PIN
  #undef MX3
  #undef GAPA
  #undef GAPB
  #undef EX
  #undef VRD
  #undef KRD
  #undef STEP
  #undef ENDW
  {auto rr=__builtin_amdgcn_permlane32_swap(__float_as_uint(l_reg),__float_as_uint(l_reg),false,false);l_reg=__uint_as_float(rr[0])+__uint_as_float(rr[1]);}
  if(hi==0)wsf[32+r32]=l_reg;asm volatile("s_waitcnt lgkmcnt(0)":::"memory");
  float rli[16];
  #pragma unroll
  for(int r=0;r<16;++r)rli[r]=__builtin_amdgcn_rcpf(wsf[32+crow(r,hi)]);
  bf16*Ow=O+(rowbase+q0+wid*QBLK)*QP+h*D;
  { bf16*stg=(bf16*)(shm+LDS_OST)+wid*2048;
    #pragma unroll
    for(int r=0;r<16;++r){const int orow=crow(r,hi);
      #pragma unroll
      for(int d0=0;d0<2;++d0)stg[orow*64+d0*32+r32]=__float2bfloat16(o[d0][r]*rli[r]);}
    asm volatile("s_waitcnt lgkmcnt(0)":::"memory");
    #pragma unroll
    for(int i=0;i<4;++i){const int row=i*8+(lane>>3),ch=lane&7; const u32x4 v=*(const u32x4*)(stg+row*64+ch*8); ATTN_STORE16(Ow+(long)row*QP+ch*8,v);} }
  asm volatile("s_waitcnt lgkmcnt(0)\n\ts_barrier":::"memory");
  #undef DMA_K
  #undef DMA_V
  #undef CMASK
  #undef START
  #undef RESC
  #undef ROT
}
constexpr int ATTN_LDS_BYTES=LDS_BYTES;
template<int THRL=8> __device__ __forceinline__ void attn_phase(char*lds,const bf16*Q,const bf16*K,const bf16*V,bf16*O,float sbound,int sel=-1){
  const int G=gridDim.x,bx=blockIdx.x; const int v=(G%8==0)?(bx%8)*(G/8)+bx/8:bx; int it_=0;
  for(int u=v;u<512;u+=G,++it_){ if(sel>=0&&it_!=sel)continue; const int un=(G==256)?((u&255)*2+(u>>8)):u;
    const int pair=un>>6,loc=un&63,b=pair>>1,hkv=pair&1,h=hkv*4+(loc>>4),qb=loc&15;
    attn_unit<THRL>(b,h,hkv,qb,Q,K,V,O,lds,sbound); }
}
#undef SBAR
#undef WAIT_BAR
}

__device__ __forceinline__ void phase_attn_naive(const Params& p, float* lds) {
    const int tid = opaque_tid();
    const bf16_t* QB = (const bf16_t*)(p.ws + WS_QB); const bf16_t* KB = (const bf16_t*)(p.ws + WS_KB); const bf16_t* VB = (const bf16_t*)(p.ws + WS_VB);
    bf16_t* AO = (bf16_t*)(p.ws + WS_AO);
    float* Ks = lds; float* Vs = lds + 64 * 64;
    const int half = tid & 1;
    for (int it = blockIdx.x; it < 512; it += gridDim.x) {
        const int b = it >> 7, hq = (it >> 4) & 7, ch = it & 15, hkv = hq >> 2;
        const int m = b * 4096 + ch * 256 + (tid >> 1);
        float q[64], o[32];
        {
            const v4u* qp = (const v4u*)(QB + (size_t)m * 512 + hq * 64);
#pragma unroll
            for (int i = 0; i < 8; ++i) { const v4u w = qp[i]; q[i * 8 + 0] = lo16(w.x); q[i * 8 + 1] = hi16(w.x); q[i * 8 + 2] = lo16(w.y); q[i * 8 + 3] = hi16(w.y); q[i * 8 + 4] = lo16(w.z); q[i * 8 + 5] = hi16(w.z); q[i * 8 + 6] = lo16(w.w); q[i * 8 + 7] = hi16(w.w); }
        }
#pragma unroll
        for (int d = 0; d < 32; ++d) o[d] = 0.f;
        float mx = -1e30f, lsum = 0.f;
        for (int kt = 0; kt < 64; ++kt) {
            __syncthreads();
            {
                const int key = tid >> 3, d8 = (tid & 7) * 8;
                const size_t off = (size_t)(b * 4096 + kt * 64 + key) * 128 + hkv * 64 + d8;
                const v4u kw = *(const v4u*)(KB + off), vw = *(const v4u*)(VB + off);
                float* kd = Ks + key * 64 + d8; float* vd = Vs + key * 64 + d8;
                kd[0] = lo16(kw.x); kd[1] = hi16(kw.x); kd[2] = lo16(kw.y); kd[3] = hi16(kw.y); kd[4] = lo16(kw.z); kd[5] = hi16(kw.z); kd[6] = lo16(kw.w); kd[7] = hi16(kw.w);
                vd[0] = lo16(vw.x); vd[1] = hi16(vw.x); vd[2] = lo16(vw.y); vd[3] = hi16(vw.y); vd[4] = lo16(vw.z); vd[5] = hi16(vw.z); vd[6] = lo16(vw.w); vd[7] = hi16(vw.w);
            }
            __syncthreads();
#pragma unroll 1
            for (int j = 0; j < 64; ++j) {
                float a0 = 0.f, a1 = 0.f; const float* kr = Ks + j * 64;
#pragma unroll
                for (int d = 0; d < 64; d += 8) {
                    const f32x4 kv = *(const f32x4*)(kr + d), kw = *(const f32x4*)(kr + d + 4);
                    a0 += q[d] * kv.x + q[d + 1] * kv.y + q[d + 2] * kv.z + q[d + 3] * kv.w; a1 += q[d + 4] * kw.x + q[d + 5] * kw.y + q[d + 6] * kw.z + q[d + 7] * kw.w;
                }
                const float sc = a0 + a1;
                if (sc > mx) {
                    const float corr = exp2f(mx - sc); lsum *= corr;
#pragma unroll
                    for (int d = 0; d < 32; ++d) o[d] *= corr;
                    mx = sc;
                }
                const float pj = exp2f(sc - mx); lsum += pj; const float* vr = Vs + j * 64 + half * 32;
#pragma unroll
                for (int d = 0; d < 32; d += 4) { const f32x4 vv = *(const f32x4*)(vr + d); o[d] += pj * vv.x; o[d + 1] += pj * vv.y; o[d + 2] += pj * vv.z; o[d + 3] += pj * vv.w; }
            }
        }
        const float il = 1.0f / lsum;
        v4u* op = (v4u*)(AO + (size_t)m * 512 + hq * 64 + half * 32);
#pragma unroll
        for (int i = 0; i < 4; ++i) { v4u w; w.x = pk2(o[i * 8] * il, o[i * 8 + 1] * il); w.y = pk2(o[i * 8 + 2] * il, o[i * 8 + 3] * il); w.z = pk2(o[i * 8 + 4] * il, o[i * 8 + 5] * il); w.w = pk2(o[i * 8 + 6] * il, o[i * 8 + 7] * il); op[i] = w; }
    }
}


struct SsmConst { double lr, li, dt; float fre, fim; };
__device__ __forceinline__ void ssm_const(const Params& p, size_t gi, int pp, SsmConst& c) {
    c.lr = (double)p.lam_re[gi * 64 + pp]; c.li = (double)p.lam_im[gi * 64 + pp]; c.dt = exp((double)p.log_dt[gi]);
    const double mag = exp(c.lr * c.dt), ar = mag * cos(c.li * c.dt), ai = mag * sin(c.li * c.dt);
    const double nr = ar - 1.0, ni = ai, den = c.lr * c.lr + c.li * c.li;
    c.fre = (float)((nr * c.lr + ni * c.li) / den); c.fim = (float)((ni * c.lr - nr * c.li) / den);
}
__device__ __forceinline__ void cpow_lam(const SsmConst& c, int k, float& re, float& im) {
    const double rev = (double)k * c.li * c.dt * 0.15915494309189533576888376337251, fr = rev - rint(rev);
    const float mag = __expf((float)((double)k * c.lr * c.dt));
    re = mag * __builtin_amdgcn_cosf((float)fr); im = mag * __builtin_amdgcn_sinf((float)fr);
}
__device__ __forceinline__ void pro_ssm_gt(const Params& p, float* lds) {
    const int tid = opaque_tid();
    float* APs = lds;
    float* Bbs = lds + 2048;
    float* Cs = lds + 4096;
    float* GT = (float*)(p.ws + WS_GT);
    constexpr int NKQ = CL / 16;
    for (int it = blockIdx.x; it < 2 * 32 * 2 * NKQ; it += gridDim.x) {
        const int kq = it % NKQ, dir = (it / NKQ) & 1, g = (it / (2 * NKQ)) & 31, l = it / (64 * NKQ);
        const size_t gi = (size_t)(l * 2 + dir) * 32 + g;
        SsmConst* CS = (SsmConst*)(lds + 6144);
        __syncthreads();
        if (tid < 64) { SsmConst c; ssm_const(p, gi, tid, c); CS[tid] = c; }
        __syncthreads();
        for (int e = tid; e < 1024; e += NTHREADS) {
            const int pp = e >> 4, q = e & 15; const SsmConst c = CS[pp];
            float re, im; cpow_lam(c, kq * 16 + q, re, im); APs[2 * e] = re; APs[2 * e + 1] = im;
            const float br = p.b_re[(gi * 64 + pp) * 16 + q], bi = p.b_im[(gi * 64 + pp) * 16 + q];
            Bbs[2 * e] = c.fre * br - c.fim * bi; Bbs[2 * e + 1] = c.fre * bi + c.fim * br;
            Cs[2 * e] = p.c_re[gi * 1024 + e]; Cs[2 * e + 1] = p.c_im[gi * 1024 + e];
        }
        __syncthreads();
        const int cc = tid & 255, co = cc >> 4, ci = cc & 15, kh = tid >> 8;
        float acc[8];
#pragma unroll
        for (int k = 0; k < 8; ++k) acc[k] = 0.f;
        for (int pp = 0; pp < 64; ++pp) {
            const float cr = Cs[2 * (co * 64 + pp)], cim = Cs[2 * (co * 64 + pp) + 1], br = Bbs[2 * (pp * 16 + ci)], bi = Bbs[2 * (pp * 16 + ci) + 1];
            const float cbr = cr * br - cim * bi, cbi = cr * bi + cim * br;
#pragma unroll
            for (int k = 0; k < 8; ++k) { const float ar = APs[2 * (pp * 16 + kh * 8 + k)], ai = APs[2 * (pp * 16 + kh * 8 + k) + 1]; acc[k] += cbr * ar - cbi * ai; }
        }
#pragma unroll
        for (int k = 0; k < 8; ++k) GT[((gi * CL) + kq * 16 + kh * 8 + k) * 256 + cc] = acc[k];
    }
    __syncthreads();
}
__device__ __forceinline__ void pro_ssm_expand(const Params& p, float* lds) {
    const int tid = opaque_tid();
    constexpr int APL = CL + 1, TB = CL / 4, W2 = CL * 2;
    float* AP = lds;
    float* Bb = lds + 2 * 64 * APL * 2;
    float* Cc = Bb + 2 * 64 * 16 * 2;
    const float* GT = (const float*)(p.ws + WS_GT);
    bf16_t* SM = (bf16_t*)(p.ws + WS_SSMM); bf16_t* SS = (bf16_t*)(p.ws + WS_SSMS); float* AL = (float*)(p.ws + WS_AL);
    for (int it = blockIdx.x; it < 256; it += gridDim.x) {
        const int tq = it & 3, g = (it >> 2) & 31, l = it >> 7, lg = l * 32 + g;
        SsmConst* CS = (SsmConst*)(Cc + 2 * 16 * 64 * 2);
        __syncthreads();
        if (tid < 128) { SsmConst c; ssm_const(p, (size_t)(l * 2 + (tid >> 6)) * 32 + g, tid & 63, c); CS[tid] = c; }
        __syncthreads();
        for (int e = tid; e < 2 * 64 * APL; e += NTHREADS) {
            const int dp = e / APL, k = e % APL;
            float re, im; cpow_lam(CS[dp], k, re, im); AP[2 * e] = re; AP[2 * e + 1] = im;
        }
        for (int e = tid; e < 2048; e += NTHREADS) {
            const int dir = e >> 10, r = e & 1023, pp = r >> 4, ci = r & 15;
            const size_t gi = (size_t)(l * 2 + dir) * 32 + g; const SsmConst c = CS[dir * 64 + pp];
            const float br = p.b_re[(gi * 64 + pp) * 16 + ci], bi = p.b_im[(gi * 64 + pp) * 16 + ci];
            Bb[2 * e] = c.fre * br - c.fim * bi; Bb[2 * e + 1] = c.fre * bi + c.fim * br;
            Cc[2 * e] = p.c_re[gi * 1024 + r]; Cc[2 * e + 1] = p.c_im[gi * 1024 + r];
        }
        __syncthreads();
        if (tq == 0 && tid < 128) { const int dir = tid >> 6, pp = tid & 63; const int e = (dir * 64 + pp) * APL + CL; AL[((size_t)(lg * 2 + dir) * 64 + pp) * 2] = AP[2 * e]; AL[((size_t)(lg * 2 + dir) * 64 + pp) * 2 + 1] = AP[2 * e + 1]; }
        const float* __restrict__ GTf = GT + ((size_t)(l * 2 + 0) * 32 + g) * CL * 256; const float* __restrict__ GTb = GT + ((size_t)(l * 2 + 1) * 32 + g) * CL * 256;
        for (int w0 = tid; w0 < TB * 16 * W2; w0 += 4 * NTHREADS) {
            f32x4 v0[4], v1[4]; int tt[4], ss[4], cc[4], hh[4];
#pragma unroll
            for (int u = 0; u < 4; ++u) {
                const int w = w0 + u * NTHREADS, rl = w / W2, within = w % W2, s_ = within >> 1, hf = within & 1, t = tq * TB + (rl >> 4), co = rl & 15;
                tt[u] = t; ss[u] = s_; cc[u] = co; hh[u] = hf;
                const int lf = t >= s_ ? t - s_ : 0, lb = s_ >= t ? s_ - t : 0;
                const float* qf = GTf + (size_t)lf * 256 + co * 16 + hf * 8; const float* qb = GTb + (size_t)lb * 256 + co * 16 + hf * 8;
                const f32x4 f0 = *(const f32x4*)qf, f1 = *(const f32x4*)(qf + 4), b0 = *(const f32x4*)qb, b1 = *(const f32x4*)(qb + 4);
                const float mf = t >= s_ ? 1.f : 0.f, mb = s_ >= t ? 1.f : 0.f;
                v0[u] = f0 * mf + b0 * mb; v1[u] = f1 * mf + b1 * mb;
            }
#pragma unroll
            for (int u = 0; u < 4; ++u) {
                const int t = tt[u], s_ = ss[u], co = cc[u], hf = hh[u];
                if (t == s_ && (co >> 3) == hf) {
                    const float dv = p.ssm_d[l * 512 + g * 16 + co]; const int j = co & 7;
                    if (j == 0) v0[u].x += dv; else if (j == 1) v0[u].y += dv; else if (j == 2) v0[u].z += dv; else if (j == 3) v0[u].w += dv;
                    else if (j == 4) v1[u].x += dv; else if (j == 5) v1[u].y += dv; else if (j == 6) v1[u].z += dv; else v1[u].w += dv;
                }
                *(v4u*)(SM + ((size_t)lg * CU + t * 16 + co) * UXW + s_ * 16 + hf * 8) = pack8(v0[u], v1[u]);
            }
        }
        for (int w = tid; w < TB * 16 * 32; w += NTHREADS) {
            const int rl = w >> 5, j0 = (w & 31) * 8, t = tq * TB + (rl >> 4), co = rl & 15, dir = j0 >> 7, p0 = (j0 & 127) >> 1, ex = dir ? CL - t : t + 1;
            float o[8];
#pragma unroll
            for (int q = 0; q < 4; ++q) {
                const int pp = p0 + q; const float cr = Cc[2 * ((dir * 16 + co) * 64 + pp)], cim = Cc[2 * ((dir * 16 + co) * 64 + pp) + 1];
                const float ar = AP[2 * ((dir * 64 + pp) * APL + ex)], ai = AP[2 * ((dir * 64 + pp) * APL + ex) + 1];
                o[2 * q] = cr * ar - cim * ai; o[2 * q + 1] = -(cr * ai + cim * ar);
            }
            v4u pk; pk.x = pk2(o[0], o[1]); pk.y = pk2(o[2], o[3]); pk.z = pk2(o[4], o[5]); pk.w = pk2(o[6], o[7]);
            *(v4u*)(SM + ((size_t)lg * CU + t * 16 + co) * UXW + CU + j0) = pk;
        }
        for (int w = tid; w < 64 * W2; w += NTHREADS) {
            const int j = tq * 64 + w / W2, within = w % W2, s = within >> 1, hf = within & 1, dir = j >> 7, pp = (j & 127) >> 1, ri = j & 1, ex = dir ? s : CL - 1 - s;
            const float ar = AP[2 * ((dir * 64 + pp) * APL + ex)], ai = AP[2 * ((dir * 64 + pp) * APL + ex) + 1];
            float o[8];
#pragma unroll
            for (int q = 0; q < 8; ++q) { const float br = Bb[2 * ((dir * 64 + pp) * 16 + hf * 8 + q)], bi = Bb[2 * ((dir * 64 + pp) * 16 + hf * 8 + q) + 1]; o[q] = ri ? (ar * bi + ai * br) : (ar * br - ai * bi); }
            v4u pk; pk.x = pk2(o[0], o[1]); pk.y = pk2(o[2], o[3]); pk.z = pk2(o[4], o[5]); pk.w = pk2(o[6], o[7]);
            *(v4u*)(SS + ((size_t)lg * 256 + j) * CU + s * 16 + hf * 8) = pk;
        }
    }
}
__device__ __forceinline__ void ssm_scan_unit(const Params& p, int l, int unit) {
    const float* SLOC = (const float*)(p.ws + WS_SLOC); const float* AL = (const float*)(p.ws + WS_AL); bf16_t* UX = (bf16_t*)(p.ws + WS_UX);
    const int i = opaque_tid();
    if (i >= 256) return;
    const int g = unit >> 1, pp = i & 63, dir = (i >> 6) & 1, b = (unit & 1) * 2 + ((i >> 7) & 1);
    const float ar = AL[((size_t)((l * 32 + g) * 2 + dir) * 64 + pp) * 2], ai = AL[((size_t)((l * 32 + g) * 2 + dir) * 64 + pp) * 2 + 1];
    float xr = 0.f, xi = 0.f;
    const float* sb = SLOC + ((size_t)g * RG + b * NCH) * 256 + dir * 128 + 2 * pp;
    constexpr int SW = 64;
    typedef float f32x2_ __attribute__((ext_vector_type(2)));
    f32x2_ win[SW];
#pragma unroll
    for (int j = 0; j < SW; ++j) { const int c = dir ? NCH - 1 - j : j; win[j] = *(const f32x2_*)(sb + (size_t)c * 256); }
#pragma unroll
    for (int j = 0; j < NCH; ++j) {
        const int c = dir ? NCH - 1 - j : j; const size_t row = (size_t)g * RG + b * NCH + c;
        const f32x2_ sv = win[j % SW];
        if (j + SW < NCH) { const int c2 = dir ? NCH - 1 - (j + SW) : j + SW; win[j % SW] = *(const f32x2_*)(sb + (size_t)c2 * 256); }
        *(unsigned*)(UX + row * UXW + CU + dir * 128 + 2 * pp) = pk2(xr, xi);
        const float nr = ar * xr - ai * xi + sv.x, ni = ar * xi + ai * xr + sv.y; xr = nr; xi = ni;
    }
}
__device__ __forceinline__ void phase_ssm_scan(const Params& p, int l) { for (int u = blockIdx.x; u < 64; u += gridDim.x) ssm_scan_unit(p, l, u); }
__device__ __forceinline__ void phase_ssm_naive(const Params& p, int l) {
    const int tid = opaque_tid(), w = tid >> 6, lane = tid & 63;
    const int gw = blockIdx.x * NWAVES + w, NGW = gridDim.x * NWAVES;
    const bf16_t* UX = (const bf16_t*)(p.ws + WS_UX);
    float* YP = (float*)(p.ws + WS_YP);
    for (int it = gw; it < 256; it += NGW) {
        const int b = it >> 6, g = (it >> 1) & 31, dir = it & 1;
        const size_t gi = (size_t)(l * 2 + dir) * 32 + g, pi = gi * 64 + lane;
        const float lr = p.lam_re[pi], li = p.lam_im[pi], dt = expf(p.log_dt[gi]);
        const float mag = expf(lr * dt), ar = mag * cosf(li * dt), ai = mag * sinf(li * dt);
        const float nr = ar - 1.0f, ni = ai, den = lr * lr + li * li;
        const float fr = (nr * lr + ni * li) / den, fi = (ni * lr - nr * li) / den;
        float bbr[16], bbi[16], cr[16], ci[16];
#pragma unroll
        for (int c = 0; c < 16; ++c) {
            const float br = p.b_re[pi * 16 + c], bi = p.b_im[pi * 16 + c];
            bbr[c] = fr * br - fi * bi; bbi[c] = fr * bi + fi * br;
            cr[c] = p.c_re[(gi * 16 + c) * 64 + lane]; ci[c] = p.c_im[(gi * 16 + c) * 64 + lane];
        }
        float xr = 0.f, xi = 0.f;
        const bf16_t* ub = UX + ((size_t)g * 256 + b * 64) * UXW;
        int t = dir ? 4095 : 0;
        const v4u* up = (const v4u*)(ub + (size_t)(t >> 6) * UXW + (t & 63) * 16);
        v4u n0 = up[0], n1 = up[1];
        for (int s = 0; s < 4096; ++s) {
            const v4u u0 = n0, u1 = n1;
            const int tn = dir ? (t > 0 ? t - 1 : 0) : (t < 4095 ? t + 1 : 4095);
            const v4u* upn = (const v4u*)(ub + (size_t)(tn >> 6) * UXW + (tn & 63) * 16);
            n0 = upn[0]; n1 = upn[1];
            const float u[16] = {lo16(u0.x), hi16(u0.x), lo16(u0.y), hi16(u0.y), lo16(u0.z), hi16(u0.z), lo16(u0.w), hi16(u0.w),
                                 lo16(u1.x), hi16(u1.x), lo16(u1.y), hi16(u1.y), lo16(u1.z), hi16(u1.z), lo16(u1.w), hi16(u1.w)};
            float bur = 0.f, bui = 0.f;
#pragma unroll
            for (int c = 0; c < 16; ++c) { bur += bbr[c] * u[c]; bui += bbi[c] * u[c]; }
            const float nxr = ar * xr - ai * xi + bur, nxi = ar * xi + ai * xr + bui; xr = nxr; xi = nxi;
            float mine = 0.f;
#pragma unroll
            for (int c = 0; c < 16; ++c) { float v = cr[c] * xr - ci[c] * xi; v = wave_sum(v, lane); if (lane == c) mine = v; }
            if (lane < 16) YP[((size_t)dir * T + b * 4096 + t) * 512 + g * 16 + lane] = mine;
            t = tn;
        }
    }
}
__device__ __forceinline__ void phase_ssmpost_naive(const Params& p, int l) {
    const bf16_t* UX = (const bf16_t*)(p.ws + WS_UX); const float* YP = (const float*)(p.ws + WS_YP); bf16_t* Z = (bf16_t*)(p.ws + WS_Z);
    const int total = T * 512;
    for (int i = blockIdx.x * NTHREADS + opaque_tid(); i < total; i += gridDim.x * NTHREADS) {
        const int m = i >> 9, ch = i & 511, b = m >> 12, t = m & 4095, g = ch >> 4, co = ch & 15;
        const float u = bf2f(UX[((size_t)g * 256 + b * 64 + (t >> 6)) * UXW + (t & 63) * 16 + co]);
        const float y = YP[(size_t)m * 512 + ch] + YP[((size_t)T + m) * 512 + ch] + p.ssm_d[l * 512 + ch] * u;
        Z[(size_t)m * 512 + ch] = (bf16_t)f2bf(gelu_tanh(y));
    }
}

__device__ __forceinline__ void phase_topk(const Params& p, float* lds) {
    const int tid = opaque_tid(), lane = tid & 63, w = tid >> 6;
    const float* AFF = (const float*)(p.ws + WS_AFF);
    int* IDX = (int*)(p.ws + WS_IDX); float* GATE = (float*)(p.ws + WS_GATE); int* INV = (int*)(p.ws + WS_INV); int* SRC = (int*)(p.ws + WS_SRC);
    unsigned* hist = (unsigned*)lds;
    unsigned* misc = hist + 1024;
    for (int uu = blockIdx.x; uu < 64; uu += gridDim.x) {
        const int b = uu >> 4, e = 2 * (uu & 7) + ((uu >> 3) & 1), be = b * 16 + e;
        const f32x4 va = *(const f32x4*)(AFF + (size_t)be * 4096 + tid * 8), vb = *(const f32x4*)(AFF + (size_t)be * 4096 + tid * 8 + 4);
        const float val[8] = {va.x, va.y, va.z, va.w, vb.x, vb.y, vb.z, vb.w};
        unsigned key[8];
#pragma unroll
        for (int i = 0; i < 8; ++i) key[i] = __float_as_uint(val[i]);
        unsigned prefix = 0u, kk = CAP;
#pragma unroll 1
        for (int pass = 0; pass < 3; ++pass) {
            const int shift = 20 - 10 * pass;
            __syncthreads();
            hist[tid] = 0u; hist[tid + 512] = 0u;
            __syncthreads();
#pragma unroll
            for (int i = 0; i < 8; ++i) if (pass == 0 || (key[i] >> (shift + 10)) == prefix) atomicAdd(&hist[(key[i] >> shift) & 1023u], 1u);
            __syncthreads();
            const unsigned h0 = hist[2 * tid], h1 = hist[2 * tid + 1], mine = h0 + h1;
            unsigned inc = mine;
#pragma unroll
            for (int o = 1; o < 64; o <<= 1) { const unsigned y = (unsigned)__builtin_amdgcn_ds_bpermute(((lane + o) & 63) << 2, (int)inc); if (lane + o < 64) inc += y; }
            if (lane == 0) misc[16 + w] = inc;
            __syncthreads();
            {
                unsigned sfx = inc - mine;
                for (int w2 = w + 1; w2 < 8; ++w2) sfx += misc[16 + w2];
                if (sfx < kk && sfx + h1 >= kk) { misc[0] = (prefix << 10) | (unsigned)(2 * tid + 1); misc[1] = kk - sfx; }
                else if (sfx + h1 < kk && sfx + mine >= kk) { misc[0] = (prefix << 10) | (unsigned)(2 * tid); misc[1] = kk - sfx - h1; }
            }
            __syncthreads();
            prefix = misc[0]; kk = misc[1];
        }
        const unsigned thr = prefix;
        unsigned cg = 0u, ce = 0u;
#pragma unroll
        for (int i = 0; i < 8; ++i) { cg += key[i] > thr ? 1u : 0u; ce += key[i] == thr ? 1u : 0u; }
        const unsigned mineval = cg | (ce << 16);
        unsigned inc = mineval;
#pragma unroll
        for (int o = 1; o < 64; o <<= 1) { const unsigned y = (unsigned)__builtin_amdgcn_ds_bpermute(((lane - o) & 63) << 2, (int)inc); if (lane >= o) inc += y; }
        __syncthreads();
        if (lane == 63) misc[8 + w] = inc;
        __syncthreads();
        unsigned woff = 0u;
        for (int w2 = 0; w2 < w; ++w2) woff += misc[8 + w2];
        const unsigned excl = woff + inc - mineval;
        unsigned gb = excl & 0xffffu, eb = excl >> 16;
#pragma unroll
        for (int i = 0; i < 8; ++i) {
            const int t = tid * 8 + i; const bool isg = key[i] > thr, ise = key[i] == thr;
            const bool sel = isg || (ise && eb < kk);
            const unsigned slot = gb + (eb < kk ? eb : kk);
            if (sel) { IDX[be * 512 + slot] = t; GATE[be * 512 + slot] = val[i]; SRC[e * 2048 + b * 512 + slot] = b * 4096 + t; }
            INV[((size_t)b * 4096 + t) * 16 + e] = sel ? (int)slot : -1;
            gb += isg ? 1u : 0u; eb += ise ? 1u : 0u;
        }
    }
}
__device__ __forceinline__ void phase_gather(const Params& p) {
    const int tid = opaque_tid(), w = tid >> 6, lane = tid & 63;
    const int gw = blockIdx.x * NWAVES + w, NGW = gridDim.x * NWAVES;
    const bf16_t* H = (const bf16_t*)(p.ws + WS_H); bf16_t* XG = (bf16_t*)(p.ws + WS_XG); const int* IDX = (const int*)(p.ws + WS_IDX);
    for (int slot = gw; slot < NE * 2048; slot += NGW) {
        const int e = slot >> 11, r = slot & 2047, b = r >> 9, c = r & 511;
        const int tok = IDX[(b * 16 + e) * 512 + c];
        const v4u* src = (const v4u*)(H + ((size_t)b * 4096 + tok) * 1024); v4u* dst = (v4u*)(XG + (size_t)slot * 1024);
        dst[lane] = src[lane]; dst[lane + 64] = src[lane + 64];
    }
}
__device__ __forceinline__ void phase_combine(const Params& p, int l, float* XD) {
    const int tid = opaque_tid(), w = tid >> 6, lane = tid & 63;
    const int gw = blockIdx.x * NWAVES + w, NGW = gridDim.x * NWAVES;
    const bf16_t* YE = (const bf16_t*)(p.ws + WS_YE); const int* INV = (const int*)(p.ws + WS_INV);
    const bf16_t* ZROW = (const bf16_t*)(p.ws + WS_ZERO);
    const float* mod = (const float*)(p.ws + WS_MOD);
    bf16_t* H = (bf16_t*)(p.ws + WS_H);
    float* XR = p.out;
    const bool next = l + 1 < DEPTH;
    const float* lnw = p.ln1_w + (next ? (l + 1) * 1024 : 0);
    int cv = (gw < T) ? INV[(size_t)gw * 16 + (lane & 15)] : -1;
    for (int m = gw; m < T; m += NGW) {
        const int b = m >> 12;
        const int cur = cv; const int mn = m + NGW;
        if (mn < T) cv = INV[(size_t)mn * 16 + (lane & 15)];
        unsigned mask = (unsigned)__ballot(lane < 16 && cur >= 0) & 0xffffu;
        const bf16_t* rows[4];
#pragma unroll
        for (int k = 0; k < 4; ++k) {
            if (mask) { const int e = __builtin_ctz(mask); mask &= mask - 1u; const int c = __builtin_amdgcn_readlane(cur, e); rows[k] = (const bf16_t*)((const unsigned char*)YE + ((size_t)e * 2048 + b * 512 + c) * 1024 * (YE_FP8 ? 1 : 2)); }
            else rows[k] = ZROW;
        }
        v2u rv[4][4];
#pragma unroll
        for (int k = 0; k < 4; ++k)
#pragma unroll
            for (int j = 0; j < 4; ++j) {
                if (YE_FP8) { rv[k][j].x = *(const unsigned*)((const unsigned char*)rows[k] + j * 256 + lane * 4); rv[k][j].y = 0u; }
                else rv[k][j] = *(const v2u*)(rows[k] + j * 256 + lane * 4);
            }
        f32x4 xv[4];
#pragma unroll
        for (int j = 0; j < 4; ++j) xv[j] = *(const f32x4*)(XR + (size_t)m * 1024 + j * 256 + lane * 4);
        float acc[16];
#pragma unroll
        for (int i = 0; i < 16; ++i) acc[i] = 0.f;
#pragma unroll
        for (int k = 0; k < 4; ++k)
#pragma unroll
            for (int j = 0; j < 4; ++j) {
                if (YE_FP8) { const unsigned w8 = rv[k][j].x; acc[j * 4] += __builtin_amdgcn_cvt_f32_fp8(w8, 0); acc[j * 4 + 1] += __builtin_amdgcn_cvt_f32_fp8(w8, 1); acc[j * 4 + 2] += __builtin_amdgcn_cvt_f32_fp8(w8, 2); acc[j * 4 + 3] += __builtin_amdgcn_cvt_f32_fp8(w8, 3); }
                else { acc[j * 4] += lo16(rv[k][j].x); acc[j * 4 + 1] += hi16(rv[k][j].x); acc[j * 4 + 2] += lo16(rv[k][j].y); acc[j * 4 + 3] += hi16(rv[k][j].y); }
            }
        while (mask) {
            const int e = __builtin_ctz(mask); mask &= mask - 1u; const int c = __builtin_amdgcn_readlane(cur, e);
            const unsigned char* row = (const unsigned char*)YE + ((size_t)e * 2048 + b * 512 + c) * 1024 * (YE_FP8 ? 1 : 2);
#pragma unroll
            for (int j = 0; j < 4; ++j) {
                if (YE_FP8) { const unsigned w8 = *(const unsigned*)(row + j * 256 + lane * 4); acc[j * 4] += __builtin_amdgcn_cvt_f32_fp8(w8, 0); acc[j * 4 + 1] += __builtin_amdgcn_cvt_f32_fp8(w8, 1); acc[j * 4 + 2] += __builtin_amdgcn_cvt_f32_fp8(w8, 2); acc[j * 4 + 3] += __builtin_amdgcn_cvt_f32_fp8(w8, 3); }
                else { const v2u wv = *(const v2u*)((const bf16_t*)row + j * 256 + lane * 4); acc[j * 4] += lo16(wv.x); acc[j * 4 + 1] += hi16(wv.x); acc[j * 4 + 2] += lo16(wv.y); acc[j * 4 + 3] += hi16(wv.y); }
            }
        }
        const float* g2 = mod + (size_t)(l * 4 + b) * 6144 + 5120;
        f32x4 gvv[4], w4[4], sh[4], sc[4];
#pragma unroll
        for (int j = 0; j < 4; ++j) gvv[j] = *(const f32x4*)(g2 + j * 256 + lane * 4);
        if (next) {
            const float* modb = mod + (size_t)((l + 1) * 4 + b) * 6144;
#pragma unroll
            for (int j = 0; j < 4; ++j) { const int col = j * 256 + lane * 4; w4[j] = *(const f32x4*)(lnw + col); sh[j] = *(const f32x4*)(modb + col); sc[j] = *(const f32x4*)(modb + 1024 + col); }
        }
        float ss = 0.f;
#pragma unroll
        for (int j = 0; j < 4; ++j) {
            const f32x4 gv = gvv[j];
            constexpr float ys = YE_FP8 ? 1.0f / YE_SCALE : 1.0f;
            xv[j].x += gv.x * ys * acc[j * 4]; xv[j].y += gv.y * ys * acc[j * 4 + 1]; xv[j].z += gv.z * ys * acc[j * 4 + 2]; xv[j].w += gv.w * ys * acc[j * 4 + 3];
            ss += xv[j].x * xv[j].x + xv[j].y * xv[j].y + xv[j].z * xv[j].z + xv[j].w * xv[j].w;
        }
#pragma unroll
        for (int j = 0; j < 4; ++j) *(f32x4*)(XD + (size_t)m * 1024 + j * 256 + lane * 4) = xv[j];
        if (next) {
            const float r = rsqrtf(wave_sum(ss, lane) * (1.0f / 1024.0f) + EPS);
#pragma unroll
            for (int j = 0; j < 4; ++j) {
                const int col = j * 256 + lane * 4;
                const float h0 = xv[j].x * r * w4[j].x * (1.f + sc[j].x) + sh[j].x, h1 = xv[j].y * r * w4[j].y * (1.f + sc[j].y) + sh[j].y, h2 = xv[j].z * r * w4[j].z * (1.f + sc[j].z) + sh[j].z, h3 = xv[j].w * r * w4[j].w * (1.f + sc[j].w) + sh[j].w;
                v2u o; o.x = pk2(h0, h1); o.y = pk2(h2, h3);
                *(v2u*)(H + (size_t)m * 1024 + col) = o;
                if (INPROJ_FP8) *(unsigned*)((unsigned char*)(p.ws + WS_H8A) + (size_t)m * 1024 + col) = pk4_fp8(h0, h1, h2, h3);
            }
        }
    }
}

#define LAS __attribute__((address_space(3)))
#define XB_TMO      128
#define XB_XCNT(j)  (256  + 64 * (j))
#define XB_XSUB(j)  (1280 + 64 * (j))
#define XB_XGEN(j)  (2304 + 64 * (j))
#define XB_TOP      3328
#define XB_TOPGEN   3392
#define XCD_BAR_WORDS 3456
#define XB_SPIN_CAP (1u << 18)

__device__ __forceinline__ unsigned xb_ld(unsigned* p)              { return __hip_atomic_load(p, __ATOMIC_RELAXED, __HIP_MEMORY_SCOPE_AGENT); }
__device__ __forceinline__ unsigned xb_add(unsigned* p, unsigned v) { return __hip_atomic_fetch_add(p, v, __ATOMIC_RELAXED, __HIP_MEMORY_SCOPE_AGENT); }
__device__ __forceinline__ unsigned xb_xcc_id() { return (unsigned)__builtin_amdgcn_s_getreg((3 << 11) | 20) & 0xFu; }
#define XB_SPIN(cond, bar) do { unsigned _sp = 0; while (cond) { __builtin_amdgcn_s_sleep(1); \
    if ((++_sp & 255u) == 0u) { if (xb_ld(&(bar)[XB_TMO])) break; if (_sp > XB_SPIN_CAP) { atomicAdd(&(bar)[XB_TMO], 1u); break; } } } } while (0)

struct XcdBarrier {
    unsigned* bar; unsigned x;
    volatile LAS unsigned* st;
};

__device__ __forceinline__ XcdBarrier xcd_barrier_post(unsigned* bar, volatile LAS unsigned* st) {
    XcdBarrier b; b.bar = bar; b.x = xb_xcc_id(); b.st = st;
    if (threadIdx.x == 0) (void)xb_add(&bar[XB_XCNT(b.x)], 1u);
    return b;
}
__device__ __forceinline__ void xcd_barrier_complete(unsigned* bar, unsigned x, unsigned& nloc, unsigned& nx) {
    const unsigned G = gridDim.x * gridDim.y * gridDim.z;
    unsigned sum, cnt, mine, sp = 0u;
    for (;;) {
        sum = 0u; cnt = 0u; mine = 0u;
#pragma unroll
        for (unsigned j = 0; j < 16; ++j) { const unsigned c = xb_ld(&bar[XB_XCNT(j)]); sum += c; cnt += (c > 0u) ? 1u : 0u; mine = (j == x) ? c : mine; }
        if (sum == G) break;
        __builtin_amdgcn_s_sleep(1);
        if ((++sp & 255u) == 0u) { if (xb_ld(&bar[XB_TMO])) break; if (sp > XB_SPIN_CAP) { atomicAdd(&bar[XB_TMO], 1u); break; } }
    }
    nloc = mine > 0u ? mine : 1u; nx = cnt > 0u ? cnt : 1u;
}

#ifndef XB_EARLY
#define XB_EARLY 1
#endif
#if XB_EARLY
#define XB_EARLY_INV() asm volatile("buffer_inv sc1" ::: "memory")
#define XB_LATE_ACQ()  asm volatile("" ::: "memory")
#else
#define XB_EARLY_INV() do {} while (0)
#define XB_LATE_ACQ()  __builtin_amdgcn_fence(__ATOMIC_ACQUIRE, "agent")
#endif
__device__ __forceinline__ void xcd_barrier(const XcdBarrier& b) {
    asm volatile("s_waitcnt vmcnt(0)" ::: "memory");
    __syncthreads();
    if (threadIdx.x == 0) {
        unsigned* bar = b.bar;
        __builtin_amdgcn_s_waitcnt(0);
        unsigned nloc = b.st[0], nx = b.st[1];
        if (nloc == 0u) { xcd_barrier_complete(bar, b.st[2], nloc, nx); b.st[0] = nloc; b.st[1] = nx; }
        const unsigned bx_ = b.st[2];
        const unsigned old = xb_add(&bar[XB_XSUB(bx_)], 1u);
        const unsigned gen = old / nloc;
        if (old + 1u == (gen + 1u) * nloc) {
            __builtin_amdgcn_fence(__ATOMIC_RELEASE, "agent");
            asm volatile("s_waitcnt vmcnt(0)" ::: "memory");
            const unsigned og = xb_add(&bar[XB_TOP], 1u);
            const unsigned tg = og / nx;
            XB_EARLY_INV();
            if (og + 1u == (tg + 1u) * nx) xb_add(&bar[XB_TOPGEN], 1u);
            else XB_SPIN(xb_ld(&bar[XB_TOPGEN]) == tg, bar);
            XB_LATE_ACQ();
            xb_add(&bar[XB_XGEN(bx_)], 1u);
            asm volatile("s_waitcnt vmcnt(0)" ::: "memory");
        } else {
            XB_EARLY_INV();
            XB_SPIN(xb_ld(&bar[XB_XGEN(bx_)]) == gen, bar);
            XB_LATE_ACQ();
            asm volatile("s_waitcnt vmcnt(0)" ::: "memory");
        }
    }
    __syncthreads();
}

constexpr int LDS_MISC_OFF_C = 131072 + 64;
constexpr int CTL_CHAIN = 4096;
constexpr int CTL_WORDS = CTL_CHAIN + DEPTH * 3 * 64 * 64;
static_assert((size_t)CTL_WORDS * 4 <= WS_ZERO, "control words end below the zero row");
__device__ __forceinline__ unsigned* chain_ctr(const Params& p, int l, int stage, int pm) { return (unsigned*)(p.ws + WS_CTL) + CTL_CHAIN + ((l * 3 + stage) * 64 + pm) * 64; }
constexpr int CTL_SCAN = 3840;
#ifndef SCAN_COUNTER
#define SCAN_COUNTER 1
#endif
constexpr int CTL_XCCTAB = 3584;
__device__ __forceinline__ void chain_signal(unsigned* ctr, bool same_l2) {
    asm volatile("s_waitcnt vmcnt(0)" ::: "memory");
    __syncthreads();
    if (threadIdx.x == 0) {
        if (!same_l2) {
            __builtin_amdgcn_fence(__ATOMIC_RELEASE, "agent");
            asm volatile("s_waitcnt vmcnt(0)" ::: "memory");
        }
        __hip_atomic_fetch_add(ctr, 1u, __ATOMIC_RELAXED, __HIP_MEMORY_SCOPE_AGENT);
    }
}
__device__ __forceinline__ void chain_wait(unsigned* ctr, unsigned need) {
    if (threadIdx.x == 0) {
        unsigned spins = 0;
        XB_EARLY_INV();
        while (__hip_atomic_load(ctr, __ATOMIC_RELAXED, __HIP_MEMORY_SCOPE_AGENT) < need) { __builtin_amdgcn_s_sleep(2); if (++spins > (1u << 22)) break; }
        XB_LATE_ACQ();
        asm volatile("s_waitcnt vmcnt(0)" ::: "memory");
    }
    __syncthreads();
}
struct FixedUnit {
    int pm, pn; bool on;
    __device__ __forceinline__ bool next(int i, pg8::Unit& u) const { if (i > 0 || !on) return false; u.pm = pm; u.pn = pn; return true; }
    __device__ __forceinline__ void a_ready(const pg8::Unit&) const {}
    __device__ __forceinline__ void done(const pg8::Unit&) const {}
};
template <class Epi>
__device__ __forceinline__ void run_unit(float* lds, const bf16_t* A, int lda, const bf16_t* Bt, int ldb, int M, int N, int K, const FixedUnit& S, const Epi& e) {
    pg8::Gemm g{A, Bt, M, N, K, lda, ldb, 1 << 20, 0, nullptr, nullptr, nullptr};
    pg8::gemm_phase<Epi, FixedUnit, false, true>((PG8_LAS unsigned char*)lds, g, S, e);
}
__device__ __forceinline__ void phase_chain(const Params& p, int l, float* lds) {
    unsigned char* ws = p.ws;
    const int G = gridDim.x, bx = blockIdx.x, v = (bx % 8) * (G / 8) + bx / 8, pm = v >> 2, pn = v & 3;
    const float* xin = l == 0 ? p.x : p.out;
    const float* mod_l = (const float*)(ws + WS_MOD) + (size_t)l * 4 * 6144;
    bool same_l2;
    {
        volatile LAS unsigned* st = (volatile LAS unsigned*)((LAS unsigned char*)lds + LDS_MISC_OFF_C);
        if (threadIdx.x == 0) {
            unsigned* tab = (unsigned*)(ws + WS_CTL) + CTL_XCCTAB; const int v0 = v & ~3; unsigned ok = 1u, first = 0u;
#pragma unroll
            for (int j = 0; j < 4; ++j) { const int vj = v0 + j, bj = (vj % (G / 8)) * 8 + vj / (G / 8); const unsigned x = xb_ld(&tab[bj]); if (j == 0) first = x; ok &= (x == first && x != 0u) ? 1u : 0u; }
            st[3] = ok;
        }
        __syncthreads();
        same_l2 = __builtin_amdgcn_readfirstlane(st[3]) != 0u;
    }
    {
        XEpiGlu e{(const bf16_t*)(ws + WS_Z), (bf16_t*)(ws + WS_SO), p.b_glu + l * 512};
        for (int rep = 0; rep < 1 + (CHAIN_REP & 1); ++rep)
        run_unit(lds, (const bf16_t*)(ws + WS_Z), 512, (const bf16_t*)(ws + WS_WGLU) + (size_t)l * 512 * 512, 512, T, 512, 512, FixedUnit{pm, pn, pn < 2}, e);
        if (pn < 2) chain_signal(chain_ctr(p, l, 0, pm), same_l2);
        else if (BG_CONVERT) bg_convert(p, l, lds, BG_B3, BG_N3, pm * 2 + pn - 2, 128);
    }
    chain_wait(chain_ctr(p, l, 0, pm), 2u);
    {
        XEpiUpChain e{(const bf16_t*)(ws + WS_GS), (const bf16_t*)(ws + WS_GA), (bf16_t*)(ws + WS_MG)};
        pg8::Gemm g{(const bf16_t*)(ws + WS_SO), (const bf16_t*)(ws + WS_WSU) + (size_t)l * 1024 * 512, T, 1024, 512, 512, 512, 1 << 20, 0, (const bf16_t*)(ws + WS_AO), (const bf16_t*)(ws + WS_WAU) + (size_t)l * 1024 * 512, nullptr};
        pg8::gemm_phase<XEpiUpChain, FixedUnit2, false, true, true>((PG8_LAS unsigned char*)lds, g, FixedUnit2{pm, pn}, e);
        chain_signal(chain_ctr(p, l, 1, pm), same_l2);
    }
    chain_wait(chain_ctr(p, l, 1, pm), 4u);
    {
        if ((CHAIN_REP >> 2) & 1) { XEpiOut e0{xin, (float*)(ws + WS_YP), mod_l}; run_unit(lds, (const bf16_t*)(ws + WS_MG), 1024, (const bf16_t*)(ws + WS_WOUT) + (size_t)l * 1024 * 1024, 1024, T, 1024, 1024, FixedUnit{pm, pn, true}, e0); }
        XEpiOut e{xin, p.out, mod_l};
        run_unit(lds, (const bf16_t*)(ws + WS_MG), 1024, (const bf16_t*)(ws + WS_WOUT) + (size_t)l * 1024 * 1024, 1024, T, 1024, 1024, FixedUnit{pm, pn, true}, e);
        chain_signal(chain_ctr(p, l, 2, pm), same_l2);
    }
    chain_wait(chain_ctr(p, l, 2, pm), 4u);
    {
        const int w = opaque_tid() >> 6, row0 = pm * 256 + pn * 64;
        for (int rep = 0; rep < 1 + ((CHAIN_REP >> 3) & 1); ++rep)
        if (MOE_FP8) phase_norm2_rowsN<ROUTER_ROWS>(p, l, p.out, lds, row0 + w, NWAVES, row0 + 64);
        else phase_norm_rows<true>(p, l, p.out, lds, row0 + w, NWAVES, row0 + 64);
    }
}

enum { PH_NORM1 = 0, PH_INPROJ, PH_QKPOST, PH_ATTN, PH_SSM, PH_SSMPOST, PH_SSMMAIN, PH_GLU, PH_UP1, PH_UP2, PH_OUT, PH_NORM2, PH_TOPK, PH_GATHER, PH_MOE1, PH_MOE2, PH_COMBINE, PH_PER_LAYER, PH_PRO, PH_PRO2, PH_CHAIN };

template <int K>
__device__ __forceinline__ void run_phase(const Params& p, int l, float* lds) {
    unsigned char* ws = p.ws;
    const float* xin = l == 0 ? p.x : p.out;
    const float* mod_l = (const float*)(ws + WS_MOD) + (size_t)l * 4 * 6144;
    if constexpr (K == PH_NORM1) phase_norm<false>(p, l, xin, lds);
    else if constexpr (K == PH_INPROJ) {
#if FAST_INPROJ
        XEpiInProj e{(bf16_t*)(ws + WS_UX), (bf16_t*)(ws + WS_QB), (bf16_t*)(ws + WS_KB), (bf16_t*)(ws + WS_VB), (bf16_t*)(ws + WS_GS), (bf16_t*)(ws + WS_GA), (const float*)(ws + WS_ROPE), p.q_norm_w + l * 64, p.k_norm_w + l * 64, 0, 1.0f};
#if INPROJ_FP8
        run_gemm<XEpiInProj, true>(lds, (const bf16_t*)(ws + WS_H), 1024, (const bf16_t*)(ws + WS_WIN) + (size_t)l * NIN * 1024, 1024, T, 512, 1024, 1 << 20, 0, e);
        {
            XEpiInProj e8 = e; e8.pn_off = 2; e8.asc = 1.0f / FP8_WSCALE;
            pg8::Gemm g{(const bf16_t*)(ws + WS_H8A), (const bf16_t*)(ws + WS_WIN8 + (size_t)l * 2816 * 1024), T, 2816, 512, 512, 512, 1 << 20, 0, nullptr, nullptr, nullptr};
            InProjF8Order S; S.c = opaque_bid(); S.so.init(T, 2816, 256, S.c);
            pg8::gemm_phase<XEpiInProj, InProjF8Order, true, true, false, false, true>((PG8_LAS unsigned char*)lds, g, S, e8);
        }
#else
        run_gemm<XEpiInProj, true>(lds, (const bf16_t*)(ws + WS_H), 1024, (const bf16_t*)(ws + WS_WIN) + (size_t)l * NIN * 1024, 1024, T, NIN, 1024, 1 << 20, 0, e);
#endif
        if (BG_CONVERT && ONE_LAUNCH && blockIdx.x >= 192) { __syncthreads(); bg_convert(p, l, lds, BG_B1, BG_N1, blockIdx.x - 192, 64); }
#else
        EpiInProj e{(bf16_t*)(ws + WS_UX), (bf16_t*)(ws + WS_VB), (bf16_t*)(ws + WS_GS), (bf16_t*)(ws + WS_GA), (float*)(ws + WS_PQK)};
        gemm_naive((const bf16_t*)(ws + WS_H), 1024, 0, (const bf16_t*)(ws + WS_WIN) + (size_t)l * NIN * 1024, 1024, 0, T, NIN, 1024, 1, e, lds);
#endif
    }
    else if constexpr (K == PH_QKPOST) { if (!FAST_INPROJ) phase_qkpost(p, l); }
#if FAST_ATTN
    else if constexpr (K == PH_ATTN) {
#if FAST_SSM
        if (blockIdx.x < 64) {
            XEpiSloc e{(float*)(ws + WS_SLOC)};
            pg8::Gemm g{(const bf16_t*)(ws + WS_UX), (const bf16_t*)(ws + WS_SSMS) + (size_t)l * 32 * 256 * CU, 32 * RG, 256, CU, UXW, CU, RG / 256, (size_t)256 * CU, nullptr, nullptr, nullptr};
            const int su = SCAN_COUNTER ? ((int)blockIdx.x & 7) * 8 + ((int)blockIdx.x >> 3) : (int)blockIdx.x;
            OneUnitOrder S{64, su};
            pg8::gemm_phase<XEpiSloc, OneUnitOrder, false, true>((PG8_LAS unsigned char*)lds, g, S, e);
            asm volatile("s_waitcnt vmcnt(0)" ::: "memory"); __syncthreads();
            ssm_scan_unit(p, l, su);
            if (SCAN_COUNTER) {
                volatile LAS unsigned* st = (volatile LAS unsigned*)((LAS unsigned char*)lds + LDS_MISC_OFF_C);
                if (threadIdx.x == 0) { unsigned* tab = (unsigned*)(ws + WS_CTL) + CTL_XCCTAB; const unsigned xa = xb_ld(&tab[blockIdx.x]), xb_ = xb_ld(&tab[blockIdx.x + 64]); st[5] = (xa == xb_ && xa != 0u) ? 1u : 0u; }
                __syncthreads();
                const bool same = __builtin_amdgcn_readfirstlane(st[5]) != 0u;
                chain_signal((unsigned*)(ws + WS_CTL) + CTL_SCAN + l * 64 + su, same);
            } else __syncthreads();
        } else if (BG_CONVERT && ONE_LAUNCH && (blockIdx.x & 1)) { bg_convert(p, l, lds, BG_B5, BG_N5, blockIdx.x - 64, 192); __syncthreads(); }
        const bool bg_mid = BG_CONVERT && ONE_LAUNCH && blockIdx.x >= 64 && !(blockIdx.x & 1);
#else
        const bool bg_mid = false;
#endif
{
            const int ln_ = opaque_tid() & 63;
            float mq = fabsf(p.q_norm_w[l * 64 + ln_]), mk = fabsf(p.k_norm_w[l * 64 + ln_]);
#pragma unroll
            for (int o_ = 32; o_ > 0; o_ >>= 1) { mq = fmaxf(mq, __int_as_float(__builtin_amdgcn_ds_bpermute((ln_ ^ o_) << 2, __float_as_int(mq)))); mk = fmaxf(mk, __int_as_float(__builtin_amdgcn_ds_bpermute((ln_ ^ o_) << 2, __float_as_int(mk)))); }
            const float sbound = fminf(QSCALE * 64.0f * mq * mk * 1.02f, 64.0f);
            if (bg_mid) {
                attn_body::attn_phase<-1>((char*)lds, (const attn_body::bf16*)(ws + WS_QB), (const attn_body::bf16*)(ws + WS_KB), (const attn_body::bf16*)(ws + WS_VB), (attn_body::bf16*)(ws + WS_AO), sbound, 0);
                __syncthreads(); bg_convert(p, l, lds, BG_B5, BG_N5, blockIdx.x - 64, 192); __syncthreads();
                attn_body::attn_phase<-1>((char*)lds, (const attn_body::bf16*)(ws + WS_QB), (const attn_body::bf16*)(ws + WS_KB), (const attn_body::bf16*)(ws + WS_VB), (attn_body::bf16*)(ws + WS_AO), sbound, 1);
            } else
                    attn_body::attn_phase<-1>((char*)lds, (const attn_body::bf16*)(ws + WS_QB), (const attn_body::bf16*)(ws + WS_KB), (const attn_body::bf16*)(ws + WS_VB), (attn_body::bf16*)(ws + WS_AO), sbound);
        }
    }
#else
    else if constexpr (K == PH_ATTN) phase_attn_naive(p, lds);
#endif
#if FAST_SSM
    else if constexpr (K == PH_SSM) {
        XEpiSloc e{(float*)(ws + WS_SLOC)};
        run_gemm<XEpiSloc, false>(lds, (const bf16_t*)(ws + WS_UX), UXW, (const bf16_t*)(ws + WS_SSMS) + (size_t)l * 32 * 256 * CU, CU, 32 * RG, 256, CU, RG / 256, (size_t)256 * CU, e);
    }
    else if constexpr (K == PH_SSMPOST) phase_ssm_scan(p, l);
    else if constexpr (K == PH_SSMMAIN) {
        if (SCAN_COUNTER && blockIdx.x < 128) chain_wait((unsigned*)(ws + WS_CTL) + CTL_SCAN + l * 64 + ((int)blockIdx.x & 7) * 8 + (((int)blockIdx.x >> 3) & 7), 1u);
        XEpiZ e{(bf16_t*)(ws + WS_Z)};
        run_gemm<XEpiZ, false>(lds, (const bf16_t*)(ws + WS_UX), UXW, (const bf16_t*)(ws + WS_SSMM) + (size_t)l * 32 * CU * UXW, UXW, 32 * RG, CU, UXW, RG / 256, (size_t)CU * UXW, e);
        if (BG_CONVERT && ONE_LAUNCH && blockIdx.x >= 128) bg_convert(p, l, lds, BG_B2, BG_N2, blockIdx.x - 128, 128);
    }
    else if constexpr (K == PH_PRO2) {
        if (blockIdx.x & 1) { phase_norm<false>(p, 0, p.x, lds); __syncthreads(); pro_ssm_expand(p, lds); }
        else { pro_ssm_expand(p, lds); __syncthreads(); phase_norm<false>(p, 0, p.x, lds); }
    }
#else
    else if constexpr (K == PH_SSM) phase_ssm_naive(p, l);
    else if constexpr (K == PH_SSMPOST) phase_ssmpost_naive(p, l);
    else if constexpr (K == PH_SSMMAIN) {}
    else if constexpr (K == PH_PRO2) phase_norm<false>(p, 0, p.x, lds);
#endif
    else if constexpr (K == PH_GLU) {
#if FAST_SMALLGEMM
        XEpiGlu e{(const bf16_t*)(ws + WS_Z), (bf16_t*)(ws + WS_SO), p.b_glu + l * 512};
        run_gemm<XEpiGlu, false>(lds, (const bf16_t*)(ws + WS_Z), 512, (const bf16_t*)(ws + WS_WGLU) + (size_t)l * 512 * 512, 512, T, 512, 512, 1 << 20, 0, e);
#else
        EpiGlu e{(const bf16_t*)(ws + WS_Z), (bf16_t*)(ws + WS_SO), p.b_glu + l * 512};
        gemm_naive((const bf16_t*)(ws + WS_Z), 512, 0, (const bf16_t*)(ws + WS_WGLU) + (size_t)l * 512 * 512, 512, 0, T, 512, 512, 1, e, lds);
#endif
    }
    else if constexpr (K == PH_UP1) {
#if FAST_SMALLGEMM
        XEpiUp<false> e{(const bf16_t*)(ws + WS_GS), (bf16_t*)(ws + WS_MG)};
        run_gemm<XEpiUp<false>, false>(lds, (const bf16_t*)(ws + WS_SO), 512, (const bf16_t*)(ws + WS_WSU) + (size_t)l * 1024 * 512, 512, T, 1024, 512, 1 << 20, 0, e);
#else
        EpiUp<false> e{(const bf16_t*)(ws + WS_GS), (bf16_t*)(ws + WS_MG)};
        gemm_naive((const bf16_t*)(ws + WS_SO), 512, 0, (const bf16_t*)(ws + WS_WSU) + (size_t)l * 1024 * 512, 512, 0, T, 1024, 512, 1, e, lds);
#endif
    }
    else if constexpr (K == PH_UP2) {
#if FAST_SMALLGEMM
        XEpiUp<true> e{(const bf16_t*)(ws + WS_GA), (bf16_t*)(ws + WS_MG)};
        run_gemm<XEpiUp<true>, false>(lds, (const bf16_t*)(ws + WS_AO), 512, (const bf16_t*)(ws + WS_WAU) + (size_t)l * 1024 * 512, 512, T, 1024, 512, 1 << 20, 0, e);
#else
        EpiUp<true> e{(const bf16_t*)(ws + WS_GA), (bf16_t*)(ws + WS_MG)};
        gemm_naive((const bf16_t*)(ws + WS_AO), 512, 0, (const bf16_t*)(ws + WS_WAU) + (size_t)l * 1024 * 512, 512, 0, T, 1024, 512, 1, e, lds);
#endif
    }
    else if constexpr (K == PH_OUT) {
#if FAST_SMALLGEMM
        XEpiOut e{xin, p.out, mod_l};
        run_gemm<XEpiOut, false>(lds, (const bf16_t*)(ws + WS_MG), 1024, (const bf16_t*)(ws + WS_WOUT) + (size_t)l * 1024 * 1024, 1024, T, 1024, 1024, 1 << 20, 0, e);
#else
        EpiOut e{xin, p.out, mod_l};
        gemm_naive((const bf16_t*)(ws + WS_MG), 1024, 0, (const bf16_t*)(ws + WS_WOUT) + (size_t)l * 1024 * 1024, 1024, 0, T, 1024, 1024, 1, e, lds);
#endif
    }
    else if constexpr (K == PH_NORM2) phase_norm<true>(p, l, p.out, lds);
    else if constexpr (K == PH_TOPK) { phase_topk(p, lds); if (BG_CONVERT && ONE_LAUNCH && blockIdx.x >= 64) bg_convert(p, l, lds, BG_B4, BG_N4, blockIdx.x - 64, 192); }
    else if constexpr (K == PH_GATHER) { if (!MOE_GATHER) phase_gather(p); }
    else if constexpr (K == PH_MOE1) {
        static_assert(FAST_MOE && MOE_GATHER, "the expert GEMMs are maintained only in their MFMA + gathered-A form");
#if MOE_FP8
        {
            XEpiMoe1F8 e{(unsigned char*)(ws + WS_HID)};
            pg8::Gemm g{(const bf16_t*)(ws + WS_H8), (const bf16_t*)(ws + WS_WGU + (size_t)l * 16 * 4096 * 1024), NE * 2048, 4096, 512, 512, 512, 8, (size_t)4096 * 512, nullptr, nullptr, (const int*)(ws + WS_SRC)};
            pg8::StaticOrder S; S.init(NE * 2048, 4096, (int)gridDim.x, (int)blockIdx.x);
            pg8::gemm_phase<XEpiMoe1F8, pg8::StaticOrder, true, true, false, true, true>((PG8_LAS unsigned char*)lds, g, S, e);
        }
#else
        {
            XEpiMoe1 e{(bf16_t*)(ws + WS_HID)};
            pg8::Gemm g{(const bf16_t*)(ws + WS_H), (const bf16_t*)(ws + WS_WGU) + (size_t)l * 16 * 4096 * 1024, NE * 2048, 4096, 1024, 1024, 1024, 8, (size_t)4096 * 1024, nullptr, nullptr, (const int*)(ws + WS_SRC)};
            pg8::StaticOrder S; S.init(NE * 2048, 4096, (int)gridDim.x, (int)blockIdx.x);
            pg8::gemm_phase<XEpiMoe1, pg8::StaticOrder, true, true, false, true>((PG8_LAS unsigned char*)lds, g, S, e);
        }
#endif
    }
    else if constexpr (K == PH_MOE2) {
#if MOE_FP8
        {
            XEpiMoe2 e{(bf16_t*)(ws + WS_YE), (const float*)(ws + WS_GATE), 1.0f / FP8_WSCALE};
            pg8::Gemm g{(const bf16_t*)(ws + WS_HID), (const bf16_t*)(ws + WS_WD + (size_t)l * 16 * 1024 * 2048), NE * 2048, 1024, 1024, 1024, 1024, 8, (size_t)1024 * 1024, nullptr, nullptr, nullptr};
            pg8::StaticOrder S; S.init(NE * 2048, 1024, (int)gridDim.x, (int)blockIdx.x);
            pg8::gemm_phase<XEpiMoe2, pg8::StaticOrder, true, true, false, false, true>((PG8_LAS unsigned char*)lds, g, S, e);
        }
#else
        XEpiMoe2 e{(bf16_t*)(ws + WS_YE), (const float*)(ws + WS_GATE), 1.0f};
        run_gemm<XEpiMoe2, true>(lds, (const bf16_t*)(ws + WS_HID), 2048, (const bf16_t*)(ws + WS_WD) + (size_t)l * 16 * 1024 * 2048, 2048, NE * 2048, 1024, 2048, 8, (size_t)1024 * 2048, e);
#endif
    }
    else if constexpr (K == PH_COMBINE) { if (COMBINE_PROBE) { phase_combine(p, l, (float*)(ws + WS_HID)); __syncthreads(); } phase_combine(p, l, p.out); }
    else if constexpr (K == PH_CHAIN) phase_chain(p, l, lds);
    else if constexpr (K == PH_PRO) {
        if (blockIdx.x & 1) { pro_weights(p, lds); __syncthreads(); pro_mod(p, lds); pro_rope(p); if (FAST_SSM) pro_ssm_gt(p, lds); }
        else { pro_mod(p, lds); pro_rope(p); if (FAST_SSM) pro_ssm_gt(p, lds); pro_weights(p, lds); }
    }
}

#if ONE_LAUNCH
constexpr int LDS_MISC_OFF = LDS_MISC_OFF_C;
constexpr int LDS_PARAMS_OFF = 131072 + 256;
constexpr int NPTR = sizeof(Params) / 8;
__device__ __forceinline__ Params params_from_lds(const LAS unsigned long long* lp) {
    unsigned a; asm volatile("v_mov_b32 %0, %1" : "=v"(a) : "s"((unsigned)(size_t)lp));
    const LAS unsigned long long* lq = (const LAS unsigned long long*)(size_t)a;
    unsigned long long tmp[NPTR];
#pragma unroll
    for (int i = 0; i < NPTR; ++i) {
        const unsigned long long v = lq[i];
        const unsigned lo = __builtin_amdgcn_readfirstlane((unsigned)v), hi = __builtin_amdgcn_readfirstlane((unsigned)(v >> 32));
        tmp[i] = ((unsigned long long)hi << 32) | lo;
    }
    typedef const __attribute__((address_space(1))) float* gcf_t;
    Params q;
    q.x = (const float*)(gcf_t)tmp[0]; q.c = (const float*)(gcf_t)tmp[1]; q.w_mod = (const float*)(gcf_t)tmp[2]; q.b_mod = (const float*)(gcf_t)tmp[3]; q.ln1_w = (const float*)(gcf_t)tmp[4];
    q.ln2_w = (const float*)(gcf_t)tmp[5]; q.w_in = (const float*)(gcf_t)tmp[6]; q.lam_re = (const float*)(gcf_t)tmp[7]; q.lam_im = (const float*)(gcf_t)tmp[8]; q.log_dt = (const float*)(gcf_t)tmp[9];
    q.b_re = (const float*)(gcf_t)tmp[10]; q.b_im = (const float*)(gcf_t)tmp[11]; q.c_re = (const float*)(gcf_t)tmp[12]; q.c_im = (const float*)(gcf_t)tmp[13]; q.ssm_d = (const float*)(gcf_t)tmp[14];
    q.w_glu = (const float*)(gcf_t)tmp[15]; q.b_glu = (const float*)(gcf_t)tmp[16]; q.q_norm_w = (const float*)(gcf_t)tmp[17]; q.k_norm_w = (const float*)(gcf_t)tmp[18]; q.w_ssm_up = (const float*)(gcf_t)tmp[19];
    q.w_attn_up = (const float*)(gcf_t)tmp[20]; q.w_out = (const float*)(gcf_t)tmp[21]; q.w_router = (const float*)(gcf_t)tmp[22]; q.w_eg = (const float*)(gcf_t)tmp[23]; q.w_eu = (const float*)(gcf_t)tmp[24];
    q.w_ed = (const float*)(gcf_t)tmp[25];
    q.out = (float*)(__attribute__((address_space(1))) float*)tmp[26]; q.ws = (unsigned char*)(__attribute__((address_space(1))) unsigned char*)tmp[27];
    static_assert(sizeof(Params) == 28 * 8, "Params = 28 pointers");
    return q;
}
__global__ void __launch_bounds__(NTHREADS, 2) mega(Params p0) {
    extern __shared__ __attribute__((aligned(16))) unsigned char lds_raw[];
    float* lds = (float*)lds_raw;
    cg::grid_group grid = cg::this_grid();
    volatile LAS unsigned* st = (volatile LAS unsigned*)((LAS unsigned char*)lds_raw + LDS_MISC_OFF);
    LAS unsigned long long* lp = (LAS unsigned long long*)((LAS unsigned char*)lds_raw + LDS_PARAMS_OFF);
    if (threadIdx.x == 0) {
        unsigned long long tmp[NPTR]; __builtin_memcpy(tmp, &p0, sizeof(p0));
#pragma unroll
        for (int i = 0; i < NPTR; ++i) lp[i] = tmp[i];
        st[0] = 0u; st[1] = 0u; st[2] = xb_xcc_id(); st[3] = 0u;
        (void)xb_add((unsigned*)(p0.ws + WS_CTL) + CTL_XCCTAB + blockIdx.x, xb_xcc_id() + 1u);
        (void)xb_add(&((unsigned*)(p0.ws + WS_CTL))[XB_XCNT(xb_xcc_id())], 1u);
    }
    __syncthreads();
#define BARRIER() do { const Params q_ = params_from_lds(lp); XcdBarrier b_; b_.bar = (unsigned*)(q_.ws + WS_CTL); b_.st = st; b_.x = 0; xcd_barrier(b_); } while (0)
#define RUN(K) do { const Params q_ = params_from_lds(lp); run_phase<K>(q_, l, lds); } while (0)
#ifndef DOUBLE_BARRIER
#define DOUBLE_BARRIER 0
#endif
#ifndef REPEAT_MASK
#define REPEAT_MASK 0
#endif
#define PHASE(K) do { RUN(K); if ((REPEAT_MASK >> (K)) & 1) { BARRIER(); RUN(K); } BARRIER(); if (DOUBLE_BARRIER) BARRIER(); } while (0)
    if (p0.ws == nullptr) grid.sync();
    { const int l = 0; RUN(PH_PRO); if ((REPEAT_MASK >> PH_PRO) & 1) { BARRIER(); RUN(PH_PRO); } BARRIER(); PHASE(PH_PRO2); }
#pragma unroll 1
    for (int l = 0; l < DEPTH; ++l) {
        PHASE(PH_INPROJ); if (SCAN_COUNTER) { RUN(PH_ATTN); } else { PHASE(PH_ATTN); } PHASE(PH_SSMMAIN); PHASE(PH_CHAIN);
        PHASE(PH_TOPK); if (!MOE_GATHER) PHASE(PH_GATHER); PHASE(PH_MOE1); PHASE(PH_MOE2);
        RUN(PH_COMBINE); if (l + 1 < DEPTH) BARRIER();
    }
#undef PHASE
#undef RUN
#undef BARRIER
}
#else
template <int K> __global__ void __launch_bounds__(NTHREADS, 2) phase_kernel(Params p, int l) {
    extern __shared__ __attribute__((aligned(16))) unsigned char lds_raw[];
    run_phase<K>(p, l, (float*)lds_raw);
}
template <int K> static bool setup_phase() { return hipFuncSetAttribute((const void*)phase_kernel<K>, hipFuncAttributeMaxDynamicSharedMemorySize, LDS_BYTES) == hipSuccess; }
template <int K> static void launch_phase(const Params& p, int l, int grid, hipStream_t stream) { hipLaunchKernelGGL(phase_kernel<K>, dim3(grid), dim3(NTHREADS), LDS_BYTES, stream, p, l); }
template <int... Ks> static bool setup_all(std::integer_sequence<int, Ks...>) { bool ok = true; ((ok = setup_phase<Ks>() && ok), ...); return ok; }
template <int... Ks> static void launch_layer(const Params& p, int l, int grid, hipStream_t stream, std::integer_sequence<int, Ks...>) { (launch_phase<Ks>(p, l, grid, stream), ...); }
#endif

extern "C" void kernel_launch(void* const* d_in, const int* in_sizes, int n_in, void* d_out, int out_size, void* d_ws, size_t ws_size, hipStream_t stream) {
    static int grid = 0;
    if (grid == 0) {
        if (n_in != 26 || out_size != T * D || ws_size < WS_END) { fprintf(stderr, "kernel_launch: unexpected shapes: n_in %d out %d ws %zu (need %zu)\n", n_in, out_size, ws_size, (size_t)WS_END); grid = -1; return; }
        int dev = 0, cus = 0, per_cu = 0;
        (void)hipGetDevice(&dev); (void)hipDeviceGetAttribute(&cus, hipDeviceAttributeMultiprocessorCount, dev);
#if ONE_LAUNCH
        if (hipFuncSetAttribute((const void*)mega, hipFuncAttributeMaxDynamicSharedMemorySize, LDS_BYTES) != hipSuccess) { fprintf(stderr, "kernel_launch: hipFuncSetAttribute failed\n"); grid = -1; return; }
        (void)hipOccupancyMaxActiveBlocksPerMultiprocessor(&per_cu, (const void*)mega, NTHREADS, LDS_BYTES);
        if (per_cu < 1) { fprintf(stderr, "kernel_launch: occupancy query says %d blocks/CU\n", per_cu); grid = -1; return; }
#else
        if (!setup_all(std::make_integer_sequence<int, PH_PRO2 + 1>{})) { fprintf(stderr, "kernel_launch: hipFuncSetAttribute failed\n"); grid = -1; return; }
        (void)per_cu;
#endif
        grid = cus;
        if (ONE_LAUNCH && grid != 256) { fprintf(stderr, "kernel_launch: the token-panel chain needs exactly 256 workgroups (one per CU of a 256-CU device); got %d CUs\n", cus); grid = -1; return; }
        (void)hipGetLastError();
    }
    if (grid < 0) return;
    Params p{};
    const float** pp = (const float**)&p;
    for (int i = 0; i < 26; ++i) pp[i] = (const float*)d_in[i];
    p.out = (float*)d_out; p.ws = (unsigned char*)d_ws;
#if ONE_LAUNCH
    (void)hipMemsetAsync((char*)d_ws + WS_CTL, 0, WS_ZERO + 2048, stream);
    void* args[] = {&p};
    hipError_t e = hipLaunchCooperativeKernel((const void*)mega, dim3(grid), dim3(NTHREADS), args, LDS_BYTES, stream);
    if (e != hipSuccess) fprintf(stderr, "cooperative launch failed: %s (grid %d)\n", hipGetErrorString(e), grid);
#else
    launch_phase<PH_PRO>(p, 0, grid, stream);
    launch_phase<PH_PRO2>(p, 0, grid, stream);
    for (int l = 0; l < DEPTH; ++l) launch_layer(p, l, grid, stream, std::make_integer_sequence<int, PH_PER_LAYER>{});
#endif
}
```
